# Optimizing an MI355X kernel written in HIP

```python
import jax, jax.numpy as jnp
from jax import lax
import numpy as np

D_MODEL = 1024
BATCH = 2
SEQ = 8192
DEPTH = 4
DEC_BATCH = 128
DEC_SEQ = 8
PAST_LEN = 2048
PAGE_SIZE = 128

N_A = DEPTH // 2
N_B = DEPTH - N_A
POOL_WINDOWS = (2, 4, 8, 16)
N_POOL_GROUPS = len(POOL_WINDOWS)
POOL_GROUP = D_MODEL // N_POOL_GROUPS
POOL_STATE = max(POOL_WINDOWS) - 1
N_HEADS = 16
HEAD_DIM = D_MODEL // N_HEADS
N_KV = 4
GROUP = N_HEADS // N_KV
CMP_LEN = 32
CMP_STRIDE = 16
CMP_HIDDEN = 256
SLC_LEN = 64
TOP_N = 16
WINDOW = 512
Q_BLOCK = 128
D_FF = 2816
CONV_W = 3
KV_SLOTS = 6
PAGED_SLOTS = 4
DN_ALPHA = (2 * DEPTH) ** 0.25
DN_BETA = (8 * DEPTH) ** -0.25
LN_EPS = 1e-5
NEG = -1e30
FORCE_BONUS = 1e4

kernel_name = 'pool_yoco_nsa_convffn_step'


def layer_norm(x, g, b):
    xf = x.astype(jnp.float32)
    mu = jnp.mean(xf, axis=-1, keepdims=True)
    var = jnp.mean(jnp.square(xf - mu), axis=-1, keepdims=True)
    return (((xf - mu) * lax.rsqrt(var + LN_EPS)) * g + b).astype(x.dtype)


def ada_params(c, w, b):
    m = jax.nn.silu(c) @ w + b
    return jnp.split(m[:, None, :], 6, axis=-1)


def modulate(x, shift, scale):
    return x * (1 + scale) + shift


def post_norm(x, delta, gate, g, b):
    return layer_norm(DN_ALPHA * x + (1 + gate) * delta, g, b)


def pool_mixer(u, prev, start_pos, w_pool, ls):
    B, T, D = u.shape
    P = POOL_STATE
    ext = jnp.concatenate([prev, u], axis=1)
    extf = ext.astype(jnp.float32)
    csum = jnp.concatenate([jnp.zeros_like(extf[:, :1]), jnp.cumsum(extf, axis=1)], axis=1)
    pos = start_pos + jnp.arange(T)
    groups = []
    for gi, w in enumerate(POOL_WINDOWS):
        sl = slice(gi * POOL_GROUP, (gi + 1) * POOL_GROUP)
        win_sum = csum[:, P + 1:P + T + 1, sl] - csum[:, P + 1 - w:P + T + 1 - w, sl]
        count = jnp.minimum(pos + 1, w).astype(jnp.float32)[None, :, None]
        groups.append(win_sum / count - extf[:, P:, sl])
    pooled = jnp.stack(groups, axis=2).astype(u.dtype)
    mixed = jnp.einsum('btgc,gce->btge', pooled, w_pool).reshape(B, T, D)
    return mixed * ls, ext[:, -P:]


def conv_ffn(u, prev, w_up, b_up, w_conv, b_conv, w_down):
    T = u.shape[1]
    h = u @ w_up + b_up
    ext = jnp.concatenate([prev, h], axis=1)
    hc = b_conv + ext[:, 0:T] * w_conv[0]
    for k in range(1, CONV_W):
        hc = hc + ext[:, k:k + T] * w_conv[k]
    a, v = jnp.split(hc, 2, axis=-1)
    return (jax.nn.silu(a) * v) @ w_down, ext[:, -(CONV_W - 1):]


def compress(rows, pe, w1, b1, w2, b2):
    B, L = rows.shape[:2]
    nc = (L - CMP_LEN) // CMP_STRIDE + 1
    idx = jnp.arange(nc)[:, None] * CMP_STRIDE + jnp.arange(CMP_LEN)[None, :]
    blk = rows[:, idx] + pe[None, None, :, None, :]
    blk = jnp.moveaxis(blk, 2, 3).reshape(B, nc, N_KV, CMP_LEN * HEAD_DIM)
    return jax.nn.gelu(blk @ w1 + b1) @ w2 + b2


def kv_context(paged_rows, win_rows, cmp_pe, cmp_w1, cmp_b1, cmp_w2, cmp_b2):
    B, L = paged_rows.shape[:2]
    kc = compress(paged_rows[:, :, 0], cmp_pe[0], cmp_w1[0], cmp_b1[0], cmp_w2[0], cmp_b2[0])
    vc = compress(paged_rows[:, :, 1], cmp_pe[1], cmp_w1[1], cmp_b1[1], cmp_w2[1], cmp_b2[1])
    cend = jnp.arange(kc.shape[1]) * CMP_STRIDE + CMP_LEN - 1
    ns = -(-L // SLC_LEN)
    slc = jnp.pad(paged_rows[:, :, 2:4], ((0, 0), (0, ns * SLC_LEN - L), (0, 0), (0, 0), (0, 0)))
    slc = slc.reshape(B, ns, SLC_LEN, 2, N_KV, HEAD_DIM).transpose(3, 0, 4, 1, 2, 5)
    return (kc, vc, cend, slc[0], slc[1], win_rows[:, :, 0], win_rows[:, :, 1])


def nsa_core(q, gates, qpos, kc, vc, cend, ks_blk, vs_blk, kw, vw, kwpos):
    B, Tq = q.shape[:2]
    scale = HEAD_DIM ** -0.5
    qg = q.reshape(B, Tq, N_KV, GROUP, HEAD_DIM)
    s_c = jnp.einsum('btgrd,bngd->bgrtn', qg, kc).astype(jnp.float32) * scale
    m_c = cend[None, :] <= qpos[:, None]
    p_c = jax.nn.softmax(jnp.where(m_c, s_c, NEG), axis=-1) * m_c
    o_c = jnp.einsum('bgrtn,bngd->btgrd', p_c.astype(q.dtype), vc)
    n_c = kc.shape[1]
    ns = ks_blk.shape[2]
    ci = jnp.arange(n_c)[:, None] * CMP_STRIDE
    sj = jnp.arange(ns)[None, :] * SLC_LEN
    overlap = ((ci <= sj + SLC_LEN - 1) & (ci + CMP_LEN - 1 >= sj)).astype(jnp.float32)
    imp = jnp.einsum('bgrtn,nj->bgtj', p_c, overlap)
    jj = jnp.arange(ns)[None, :]
    cur = (qpos // SLC_LEN)[:, None]
    forced = (jj == 0) | (jj == cur) | (jj == cur - 1)
    valid = jj * SLC_LEN <= qpos[:, None]
    imp = jnp.where(valid, imp + FORCE_BONUS * forced, NEG)
    n_sel = min(TOP_N, ns)
    _, sel = lax.top_k(imp, n_sel)
    gather = jax.vmap(jax.vmap(lambda blk, ix: blk[ix]))
    ksel = gather(ks_blk, sel)
    vsel = gather(vs_blk, sel)
    s_s = jnp.einsum('btgrd,bgtnkd->bgrtnk', qg, ksel).astype(jnp.float32) * scale
    kpos = sel[..., None] * SLC_LEN + jnp.arange(SLC_LEN)
    m_s = (kpos <= qpos[None, None, :, None, None])[:, :, None]
    s_s = jnp.where(m_s, s_s, NEG).reshape(B, N_KV, GROUP, Tq, n_sel * SLC_LEN)
    p_s = jax.nn.softmax(s_s, axis=-1).reshape(B, N_KV, GROUP, Tq, n_sel, SLC_LEN)
    o_s = jnp.einsum('bgrtnk,bgtnkd->btgrd', p_s.astype(q.dtype), vsel)
    s_w = jnp.einsum('btgrd,bkgd->bgrtk', qg, kw).astype(jnp.float32) * scale
    dist = qpos[:, None] - kwpos[None, :]
    m_w = (dist >= 0) & (dist < WINDOW) & (kwpos[None, :] >= 0)
    p_w = jax.nn.softmax(jnp.where(m_w, s_w, NEG), axis=-1)
    o_w = jnp.einsum('bgrtk,bkgd->btgrd', p_w.astype(q.dtype), vw)
    o = jnp.stack([o_c, o_s, o_w], axis=-1).reshape(B, Tq, N_HEADS, HEAD_DIM, 3)
    return jnp.einsum('bthdi,bthi->bthd', o, gates)


def nsa_prompt(q, gates, ctx):
    kc, vc, cend, ks_blk, vs_blk, kw, vw = ctx
    B, T = q.shape[:2]
    nqb = T // Q_BLOCK
    pad = ((0, 0), (WINDOW, 0), (0, 0), (0, 0))
    kw_pad = jnp.pad(kw, pad)
    vw_pad = jnp.pad(vw, pad)

    def one_block(i):
        s = i * Q_BLOCK
        qb = lax.dynamic_slice_in_dim(q, s, Q_BLOCK, axis=1)
        gb = lax.dynamic_slice_in_dim(gates, s, Q_BLOCK, axis=1)
        kwb = lax.dynamic_slice_in_dim(kw_pad, s, WINDOW + Q_BLOCK, axis=1)
        vwb = lax.dynamic_slice_in_dim(vw_pad, s, WINDOW + Q_BLOCK, axis=1)
        qpos = s + jnp.arange(Q_BLOCK)
        kwpos = s - WINDOW + jnp.arange(WINDOW + Q_BLOCK)
        return nsa_core(qb, gb, qpos, kc, vc, cend, ks_blk, vs_blk, kwb, vwb, kwpos)

    out = lax.map(one_block, jnp.arange(nqb))
    return jnp.moveaxis(out, 0, 1).reshape(B, T, N_HEADS, HEAD_DIM)


def nsa_sample(q, gates, ctx):
    kc, vc, cend, ks_blk, vs_blk, kw, vw = ctx
    T = q.shape[1]
    Lw = kw.shape[1]
    qpos = PAST_LEN + jnp.arange(T)
    kwpos = PAST_LEN + T - Lw + jnp.arange(Lw)
    return nsa_core(q, gates, qpos, kc, vc, cend, ks_blk, vs_blk, kw, vw, kwpos)


def run_trunk(x, c, pool_prev, conv_prev, start_pos, make_ctx, attend,
              ada_w, ada_b, ln_g, ln_b, pool_w, pool_ls,
              ffn_w_up, ffn_b_up, ffn_w_conv, ffn_b_conv, ffn_w_down,
              w_kv, nsa_w_qg, nsa_w_o):
    B, T, _ = x.shape
    hq = N_HEADS * HEAD_DIM
    pool_new, conv_new = [], []
    kv, ctx = None, None
    for l in range(DEPTH):
        sh1, sc1, g1, sh2, sc2, g2 = ada_params(c, ada_w[l], ada_b[l])
        u = modulate(x, sh1, sc1)
        if l < N_A:
            mix, pst = pool_mixer(u, pool_prev[l], start_pos, pool_w[l], pool_ls[l])
            pool_new.append(pst)
        else:
            j = l - N_A
            qgt = u @ nsa_w_qg[j]
            q = qgt[..., :hq].reshape(B, T, N_HEADS, HEAD_DIM)
            gates = jax.nn.sigmoid(qgt[..., hq:]).reshape(B, T, N_HEADS, 3)
            mix = attend(q, gates, ctx).reshape(B, T, hq) @ nsa_w_o[j]
        x = post_norm(x, mix, g1, ln_g[l, 0], ln_b[l, 0])
        f, cst = conv_ffn(modulate(x, sh2, sc2), conv_prev[l], ffn_w_up[l], ffn_b_up[l],
                          ffn_w_conv[l], ffn_b_conv[l], ffn_w_down[l])
        conv_new.append(cst)
        x = post_norm(x, f, g2, ln_g[l, 1], ln_b[l, 1])
        if l == N_A - 1:
            kv = (x @ w_kv).reshape(B, T, KV_SLOTS, N_KV, HEAD_DIM)
            ctx = make_ctx(kv)
    return x, kv, jnp.stack(pool_new), jnp.stack(conv_new)


def setup_inputs(seed: int = 0) -> dict:
    key = jax.random.key(seed)
    keys = iter(jax.random.split(key, 40))

    def nrm(shape, s):
        return jax.random.normal(next(keys), shape, jnp.float32) * s

    n_pages = PAST_LEN // PAGE_SIZE
    n_used = DEC_BATCH * n_pages
    n_phys = n_used + max(1, n_used // 4)
    wbuf = min(WINDOW, PAST_LEN)
    page_table = jax.random.permutation(next(keys), n_phys)[:n_used].reshape(DEC_BATCH, n_pages).astype(jnp.int32)
    d, f2, hq = D_MODEL, 2 * D_FF, N_HEADS * HEAD_DIM
    return {
        'x_prompt': nrm((BATCH, SEQ, d), 1.0),
        'x_sample': nrm((DEC_BATCH, DEC_SEQ, d), 1.0),
        'cache_kv': nrm((n_phys, PAGE_SIZE, PAGED_SLOTS, N_KV, HEAD_DIM), 1.0),
        'state_kv_win': nrm((DEC_BATCH, wbuf, 2, N_KV, HEAD_DIM), 1.0),
        'state_pool': nrm((N_A, DEC_BATCH, POOL_STATE, d), 1.0),
        'state_conv': nrm((DEPTH, DEC_BATCH, CONV_W - 1, f2), 1.0),
        'page_table': page_table,
        'c_prompt': nrm((BATCH, d), 1.0),
        'c_sample': nrm((DEC_BATCH, d), 1.0),
        'ada_w': nrm((DEPTH, d, 6 * d), 0.5 * d ** -0.5),
        'ada_b': nrm((DEPTH, 6 * d), 0.01),
        'ln_g': 1.0 + nrm((DEPTH, 2, d), 0.05),
        'ln_b': nrm((DEPTH, 2, d), 0.02),
        'pool_w': nrm((N_A, N_POOL_GROUPS, POOL_GROUP, POOL_GROUP), DN_BETA * POOL_GROUP ** -0.5),
        'pool_ls': 1.0 + nrm((N_A, d), 0.05),
        'ffn_w_up': nrm((DEPTH, d, f2), d ** -0.5),
        'ffn_b_up': nrm((DEPTH, f2), 0.01),
        'ffn_w_conv': nrm((DEPTH, CONV_W, f2), CONV_W ** -0.5),
        'ffn_b_conv': nrm((DEPTH, f2), 0.01),
        'ffn_w_down': nrm((DEPTH, D_FF, d), DN_BETA * D_FF ** -0.5),
        'w_kv': nrm((d, KV_SLOTS * N_KV * HEAD_DIM), d ** -0.5),
        'cmp_pe': nrm((2, CMP_LEN, HEAD_DIM), 0.1),
        'cmp_w1': nrm((2, CMP_LEN * HEAD_DIM, CMP_HIDDEN), (CMP_LEN * HEAD_DIM) ** -0.5),
        'cmp_b1': nrm((2, CMP_HIDDEN), 0.01),
        'cmp_w2': nrm((2, CMP_HIDDEN, HEAD_DIM), 2.0 * CMP_HIDDEN ** -0.5),
        'cmp_b2': nrm((2, HEAD_DIM), 0.01),
        'nsa_w_qg': nrm((N_B, d, hq + 3 * N_HEADS), d ** -0.5),
        'nsa_w_o': nrm((N_B, hq, d), DN_BETA * hq ** -0.5),
    }


def reference(x_prompt, x_sample, cache_kv, state_kv_win, state_pool, state_conv, page_table,
              c_prompt, c_sample, ada_w, ada_b, ln_g, ln_b, pool_w, pool_ls,
              ffn_w_up, ffn_b_up, ffn_w_conv, ffn_b_conv, ffn_w_down,
              w_kv, cmp_pe, cmp_w1, cmp_b1, cmp_w2, cmp_b2, nsa_w_qg, nsa_w_o):
    weights = (ada_w, ada_b, ln_g, ln_b, pool_w, pool_ls, ffn_w_up, ffn_b_up, ffn_w_conv,
               ffn_b_conv, ffn_w_down, w_kv, nsa_w_qg, nsa_w_o)
    wbuf = min(WINDOW, PAST_LEN)
    n_pages = PAST_LEN // PAGE_SIZE

    def prompt_ctx(kv):
        return kv_context(kv[:, :, :PAGED_SLOTS], kv[:, :, PAGED_SLOTS:],
                          cmp_pe, cmp_w1, cmp_b1, cmp_w2, cmp_b2)

    pool0 = jnp.zeros((N_A, BATCH, POOL_STATE, D_MODEL), x_prompt.dtype)
    conv0 = jnp.zeros((DEPTH, BATCH, CONV_W - 1, 2 * D_FF), x_prompt.dtype)
    y_prompt, kv_p, pool_p, conv_p = run_trunk(x_prompt, c_prompt, pool0, conv0, 0,
                                               prompt_ctx, nsa_prompt, *weights)

    def sample_ctx(kv):
        past = cache_kv[page_table].reshape(DEC_BATCH, n_pages * PAGE_SIZE, PAGED_SLOTS, N_KV, HEAD_DIM)
        rows = jnp.concatenate([past, kv[:, :, :PAGED_SLOTS]], axis=1)
        win = jnp.concatenate([state_kv_win, kv[:, :, PAGED_SLOTS:]], axis=1)
        return kv_context(rows, win, cmp_pe, cmp_w1, cmp_b1, cmp_w2, cmp_b2)

    y_sample, kv_s, pool_s, conv_s = run_trunk(x_sample, c_sample, state_pool, state_conv, PAST_LEN,
                                               sample_ctx, nsa_sample, *weights)
    win_s = jnp.concatenate([state_kv_win, kv_s[:, :, PAGED_SLOTS:]], axis=1)[:, -wbuf:]
    win_p = kv_p[:, -min(WINDOW, SEQ):, PAGED_SLOTS:]
    return (y_prompt, y_sample, kv_p[:, :, :PAGED_SLOTS], kv_s[:, :, :PAGED_SLOTS], win_p, win_s,
            pool_p, pool_s, conv_p, conv_s)
```

```cpp
#include <hip/hip_runtime.h>
#include <cstdio>
#include <cstdint>
namespace pg8 {
#define PG8_LAS __attribute__((address_space(3)))
typedef unsigned short bf16_t;
typedef short bf16x8 __attribute__((ext_vector_type(8)));
typedef float f32x4 __attribute__((ext_vector_type(4)));
typedef unsigned u32x4 __attribute__((ext_vector_type(4)));
constexpr int BM = 256, BK = 64, HALF = 128, HTB = HALF * BK * 2  , STAGE_BYTES = 8 * HTB, NXCD = 8, WGM = 8;

__host__ __device__ __forceinline__ int lds_byte(int r, int c) { const int st = (r >> 4) * 2 + (c >> 5), rr = r & 15, cc = c & 31, ob = rr * 64 + cc * 2; return st * 1024 + (ob ^ (((ob >> 9) & 1) << 5)); }
__host__ __device__ __forceinline__ void stage_rc(int b, int& R, int& C) { const int st = b / 1024, sb = b % 1024, swz = sb ^ (((sb >> 9) & 1) << 5); R = (st >> 1) * 16 + swz / 64; C = (st & 1) * 32 + (swz % 64) / 2; }
__host__ __device__ __forceinline__ int perm32(int rho) { const int n = rho >> 4, i = rho & 15; return 8 * (i >> 2) + 4 * n + (i & 3); }

struct Unit { int pm, pn; };
struct Gemm { const bf16_t* A; const bf16_t* Bt; int M, N, K; int lda; int bdiag; };

struct StaticOrder {
    int nM, nN, nwg, G, c;
    __host__ __device__ void init(int M, int N, int G_, int c_) { nM = M / BM; nN = N / BM; nwg = nM * nN; G = G_; c = c_; }
    __host__ __device__ bool next(int i, Unit& u) const {
        const long L = (long)i * G + c; if (L >= nwg) return false;
        int wgid = (int)L; { const int q = nwg / NXCD, r = nwg % NXCD, xcd = wgid % NXCD, off = wgid / NXCD; wgid = (xcd < r ? xcd * (q + 1) : r * (q + 1) + (xcd - r) * q) + off; }
        const int nig = WGM * nN, gid = wgid / nig, fm = gid * WGM, r_ = wgid - gid * nig, rem = nM % WGM;
        if ((nM - fm) < WGM) { u.pm = fm + r_ % rem; u.pn = r_ / rem; } else { u.pm = fm + (r_ & (WGM - 1)); u.pn = r_ / WGM; } return true;
    }
    __device__ __forceinline__ void a_ready(const Unit&) const {}
    __device__ __forceinline__ void done(const Unit&) const {}
};


__device__ __forceinline__ unsigned cvt_pk_bf16(float lo, float hi) { unsigned r; asm volatile("v_cvt_pk_bf16_f32 %0, %1, %2" : "=v"(r) : "v"(lo), "v"(hi)); return r; }

struct EpiF32 {
    static constexpr bool PERM = false, AFTER_DRAIN = false;
    float* O; int ldc; const float* bias; const float* cs;
    __device__ __forceinline__ void operator()(const f32x4 (&acc)[2][2][4][2], const Unit& u, int wr, int wc, int fr, int fq) const {
        const int row0 = u.pm * BM + wr * 64 + fr, col0 = u.pn * BM + wc * 32 + 4 * fq;
#pragma unroll
        for (int bj = 0; bj < 2; ++bj)
#pragma unroll
            for (int n = 0; n < 2; ++n) { const int c = col0 + bj * HALF + n * 16;
                const f32x4 bv = bias ? *(const f32x4*)(bias + c) : (f32x4){0.f, 0.f, 0.f, 0.f};
                const f32x4 sv = cs ? *(const f32x4*)(cs + c) : (f32x4){1.f, 1.f, 1.f, 1.f};
#pragma unroll
                for (int ai = 0; ai < 2; ++ai)
#pragma unroll
                    for (int m = 0; m < 4; ++m) *(f32x4*)(O + (size_t)(row0 + ai * HALF + m * 16) * ldc + c) = (acc[ai][bj][m][n] + bv) * sv; }
    }
};
struct EpiB16 {
    static constexpr bool PERM = true, AFTER_DRAIN = false;
    bf16_t* O; int ldc; const float* bias;
    __device__ __forceinline__ void operator()(const f32x4 (&acc)[2][2][4][2], const Unit& u, int wr, int wc, int fr, int fq) const {
        const int row0 = u.pm * BM + wr * 64 + fr, col0 = u.pn * BM + wc * 32 + 8 * fq;
        f32x4 bv[2][2];
#pragma unroll
        for (int bj = 0; bj < 2; ++bj)
#pragma unroll
            for (int n = 0; n < 2; ++n) bv[bj][n] = bias ? *(const f32x4*)(bias + col0 + bj * HALF + 4 * n) : (f32x4){0.f, 0.f, 0.f, 0.f};
#pragma unroll
        for (int ai = 0; ai < 2; ++ai)
#pragma unroll
            for (int m = 0; m < 4; ++m) { bf16_t* rowp = O + (size_t)(row0 + ai * HALF + m * 16) * ldc + col0;
#pragma unroll
                for (int bj = 0; bj < 2; ++bj) { const f32x4 v0 = acc[ai][bj][m][0] + bv[bj][0], v1 = acc[ai][bj][m][1] + bv[bj][1];
                    u32x4 w; w.x = cvt_pk_bf16(v0[0], v0[1]); w.y = cvt_pk_bf16(v0[2], v0[3]); w.z = cvt_pk_bf16(v1[0], v1[1]); w.w = cvt_pk_bf16(v1[2], v1[3]);
                    *(u32x4*)(rowp + bj * HALF) = w; } }
    }
};
struct EpiKV {
    static constexpr bool PERM = true, AFTER_DRAIN = false;
    bf16_t* KVb; float* kvp; float* kvs; float* winp; float* wins;
    __device__ __forceinline__ void operator()(const f32x4 (&acc)[2][2][4][2], const Unit& u, int wr, int wc, int fr, int fq) const {
        const int row0 = u.pm * BM + wr * 64 + fr, col0 = u.pn * BM + wc * 32 + 8 * fq;
#pragma unroll
        for (int ai = 0; ai < 2; ++ai)
#pragma unroll
            for (int m = 0; m < 4; ++m) { const int row = row0 + ai * HALF + m * 16;
#pragma unroll
                for (int bj = 0; bj < 2; ++bj) { const int col = col0 + bj * HALF; const f32x4 v0 = acc[ai][bj][m][0], v1 = acc[ai][bj][m][1];
                    u32x4 w; w.x = cvt_pk_bf16(v0[0], v0[1]); w.y = cvt_pk_bf16(v0[2], v0[3]); w.z = cvt_pk_bf16(v1[0], v1[1]); w.w = cvt_pk_bf16(v1[2], v1[3]);
                    *(u32x4*)(KVb + (size_t)row * 1536 + col) = w;
                    float* dst = nullptr;
                    if (row < 16384) { const int t = row & 8191, b = row >> 13;
                        if (col < 1024) dst = kvp + (size_t)row * 1024 + col;
                        else if (t >= 7680) dst = winp + ((size_t)(b * 512 + (t - 7680)) * 512 + (col - 1024)); }
                    else { const int rs = row - 16384;
                        if (col < 1024) dst = kvs + (size_t)rs * 1024 + col;
                        else dst = wins + ((size_t)((rs >> 3) * 512 + 504 + (rs & 7)) * 512 + (col - 1024)); }
                    if (dst) { *(f32x4*)dst = v0; *(f32x4*)(dst + 4) = v1; } } }
    }
};
struct EpiQG {
    static constexpr bool PERM = true, AFTER_DRAIN = false;
    bf16_t* Qb; float* G; float qscale;
    __device__ __forceinline__ void operator()(const f32x4 (&acc)[2][2][4][2], const Unit& u, int wr, int wc, int fr, int fq) const {
        const int row0 = u.pm * BM + wr * 64 + fr, col0 = u.pn * BM + wc * 32 + 8 * fq;
#pragma unroll
        for (int ai = 0; ai < 2; ++ai)
#pragma unroll
            for (int m = 0; m < 4; ++m) { const int row = row0 + ai * HALF + m * 16;
#pragma unroll
                for (int bj = 0; bj < 2; ++bj) { const int col = col0 + bj * HALF; f32x4 v0 = acc[ai][bj][m][0], v1 = acc[ai][bj][m][1];
                    if (col < 1024) { v0 = v0 * qscale; v1 = v1 * qscale;
                        u32x4 w; w.x = cvt_pk_bf16(v0[0], v0[1]); w.y = cvt_pk_bf16(v0[2], v0[3]); w.z = cvt_pk_bf16(v1[0], v1[1]); w.w = cvt_pk_bf16(v1[2], v1[3]);
                        *(u32x4*)(Qb + (size_t)row * 1024 + col) = w; }
                    else if (col < 1072) { float* gp = G + (size_t)row * 48 + (col - 1024);
#pragma unroll
                        for (int i = 0; i < 4; ++i) { gp[i] = 1.f / (1.f + __expf(-v0[i])); gp[4 + i] = 1.f / (1.f + __expf(-v1[i])); } } } }
    }
};
template <class Epi, class Sched, bool ALIGN_EPI = false, bool SP2 = false>
__device__ __forceinline__ void gemm_phase(PG8_LAS unsigned char* lds, const Gemm g, const Sched& S, const Epi& E) {
    int tid = threadIdx.x; asm volatile("" : "+v"(tid));
    const int wid = __builtin_amdgcn_readfirstlane(tid >> 6), lane = tid & 63, wr = wid >> 2, wc = wid & 3, fr = lane & 15, fq = lane >> 4;
    int K = g.K; asm volatile("" : "+s"(K)); const int nt = K / BK;
    unsigned voffA[2], voffB[2];
#pragma unroll
    for (int i = 0; i < 2; ++i) { int R, C; stage_rc(tid * 16 + i * 8192, R, C); const int Rb = Epi::PERM ? ((R & ~31) + perm32(R & 31)) : R;
        voffA[i] = (unsigned)(R * g.lda + C) * 2u; voffB[i] = (unsigned)(Rb * K + C) * 2u; }
    const size_t kstep = (size_t)(BK * 2);
    const size_t hstepA = (size_t)HALF * g.lda * 2, hstepB = (size_t)HALF * K * 2;
    const size_t tstepA = 2 * hstepA, tstepB = 2 * hstepB;
    const size_t dstep = g.bdiag ? (size_t)K * 2 : 0;
    const unsigned ldsw = (unsigned)wid * 1024u;
    const int aoff = lds_byte(wr * 64 + fr, fq * 8), boff = lds_byte(wc * 32 + fr, fq * 8);
#define PG8_SA(b, h) (((b) * 2 + (h)) * HTB)
#define PG8_SB(b, h) ((4 + (b) * 2 + (h)) * HTB)
#define PG8_STAGE(bufoff, gbase, voff) do { _Pragma("unroll") for (int _i = 0; _i < 2; ++_i) \
        __builtin_amdgcn_global_load_lds((const unsigned*)((const char*)(gbase) + (voff)[_i]), (PG8_LAS unsigned*)(lds + (bufoff) + ldsw + _i * 8192), 16, 0, 0); } while (0)
#define PG8_LDA(dst, b, h) do { _Pragma("unroll") for (int m = 0; m < 4; ++m) _Pragma("unroll") for (int k = 0; k < 2; ++k) dst[m][k] = *(const PG8_LAS bf16x8*)(lds + PG8_SA(b, h) + aoff + m * 2048 + k * 1024); } while (0)
#define PG8_LDB(dst, b, h) do { _Pragma("unroll") for (int n = 0; n < 2; ++n) _Pragma("unroll") for (int k = 0; k < 2; ++k) dst[n][k] = *(const PG8_LAS bf16x8*)(lds + PG8_SB(b, h) + boff + n * 2048 + k * 1024); } while (0)
#define PG8_MMA(ai, bj, At, Bt) do { __builtin_amdgcn_s_setprio(1); _Pragma("unroll") for (int m = 0; m < 4; ++m) _Pragma("unroll") for (int n = 0; n < 2; ++n) _Pragma("unroll") for (int k = 0; k < 2; ++k) \
        acc[ai][bj][m][n] = __builtin_amdgcn_mfma_f32_16x16x32_bf16(Bt[n][k], At[m][k], acc[ai][bj][m][n], 0, 0, 0); __builtin_amdgcn_s_setprio(0); } while (0)
#define PG8_WAIT_V(n) asm volatile("s_waitcnt vmcnt(" #n ")" ::: "memory")
#define PG8_WAIT_L(n) asm volatile("s_waitcnt lgkmcnt(" #n ")" ::: "memory")
#define PG8_BAR __builtin_amdgcn_s_barrier()
#define PG8_SCHED __builtin_amdgcn_sched_barrier(0)
    Unit cur, nxt; int ui = 0;
    if (!S.next(0, cur)) return;
    f32x4 acc[2][2][4][2];
#pragma unroll
    for (int a = 0; a < 2; ++a)
#pragma unroll
        for (int b = 0; b < 2; ++b)
#pragma unroll
            for (int m = 0; m < 4; ++m)
#pragma unroll
                for (int n = 0; n < 2; ++n) acc[a][b][m][n] = (f32x4){0.f, 0.f, 0.f, 0.f};
    bf16x8 At[4][2], B0[2][2], B1[2][2];
    const char* cA = (const char*)g.A + (size_t)cur.pm * tstepA + (size_t)cur.pn * dstep; const char* cB = (const char*)g.Bt + (size_t)cur.pn * tstepB;
    S.a_ready(cur);
    if constexpr (SP2) {
        PG8_STAGE(PG8_SB(0, 0), cB, voffB); PG8_STAGE(PG8_SB(0, 1), cB + hstepB, voffB); PG8_STAGE(PG8_SA(0, 0), cA, voffA); PG8_STAGE(PG8_SA(0, 1), cA + hstepA, voffA);
        if (wr == 1) PG8_BAR;
        PG8_WAIT_V(2); PG8_BAR;
        PG8_STAGE(PG8_SB(1, 0), cB + kstep, voffB); PG8_STAGE(PG8_SA(1, 0), cA + kstep, voffA); PG8_STAGE(PG8_SB(1, 1), cB + hstepB + kstep, voffB);
        PG8_WAIT_V(6); PG8_BAR;
    } else {
        PG8_STAGE(PG8_SB(0, 0), cB, voffB); PG8_STAGE(PG8_SA(0, 0), cA, voffA); PG8_STAGE(PG8_SB(0, 1), cB + hstepB, voffB); PG8_STAGE(PG8_SA(0, 1), cA + hstepA, voffA);
        if (wr == 1) PG8_BAR;
        PG8_WAIT_V(4); PG8_BAR;
        PG8_STAGE(PG8_SB(1, 0), cB + kstep, voffB); PG8_STAGE(PG8_SA(1, 0), cA + kstep, voffA); PG8_STAGE(PG8_SB(1, 1), cB + hstepB + kstep, voffB);
        PG8_WAIT_V(6); PG8_BAR;
    }
    for (;;) {
        const bool has_next = S.next(ui + 1, nxt);
        const char* nA = has_next ? (const char*)g.A + (size_t)nxt.pm * tstepA + (size_t)nxt.pn * dstep : cA; const char* nB = has_next ? (const char*)g.Bt + (size_t)nxt.pn * tstepB : cB;
        for (int t = 0; t < nt; t += 2) {
            const bool last = (t == nt - 2);
            const char* a1 = cA + (size_t)(t + 1) * kstep;
            const char* a2 = last ? nA : cA + (size_t)(t + 2) * kstep; const char* b2 = last ? nB : cB + (size_t)(t + 2) * kstep;
            const char* a3 = a2 + kstep; const char* b3 = b2 + kstep;
            if (last && has_next) S.a_ready(nxt);
            if constexpr (SP2) {
            PG8_LDB(B0, 0, 0); PG8_LDB(B1, 0, 1); PG8_SCHED; PG8_LDA(At, 0, 0); PG8_STAGE(PG8_SA(1, 1), a1 + hstepA, voffA);
            PG8_WAIT_V(8); PG8_WAIT_L(0); PG8_BAR; PG8_MMA(0, 0, At, B0); PG8_MMA(0, 1, At, B1); PG8_BAR; PG8_SCHED;
            PG8_LDA(At, 0, 1); PG8_STAGE(PG8_SB(0, 0), b2, voffB); PG8_STAGE(PG8_SB(0, 1), b2 + hstepB, voffB); PG8_STAGE(PG8_SA(0, 0), a2, voffA);
            PG8_WAIT_V(8); PG8_WAIT_L(0); PG8_BAR; PG8_MMA(1, 0, At, B0); PG8_MMA(1, 1, At, B1); PG8_BAR; PG8_SCHED;
            PG8_LDB(B0, 1, 0); PG8_LDB(B1, 1, 1); PG8_SCHED; PG8_LDA(At, 1, 0); PG8_STAGE(PG8_SA(0, 1), a2 + hstepA, voffA);
            PG8_WAIT_V(8); PG8_WAIT_L(0); PG8_BAR; PG8_MMA(0, 0, At, B0); PG8_MMA(0, 1, At, B1); PG8_BAR; PG8_SCHED;
            PG8_LDA(At, 1, 1); PG8_STAGE(PG8_SB(1, 0), b3, voffB); PG8_STAGE(PG8_SB(1, 1), b3 + hstepB, voffB); PG8_STAGE(PG8_SA(1, 0), a3, voffA);
            PG8_WAIT_V(8); PG8_WAIT_L(0); PG8_BAR; PG8_MMA(1, 0, At, B0); PG8_MMA(1, 1, At, B1); PG8_BAR; PG8_SCHED;
            } else {
            PG8_LDB(B0, 0, 0); PG8_SCHED; PG8_LDA(At, 0, 0); PG8_STAGE(PG8_SA(1, 1), a1 + hstepA, voffA);
            PG8_WAIT_L(8); PG8_BAR; PG8_WAIT_L(0); PG8_MMA(0, 0, At, B0); PG8_BAR; PG8_SCHED;
            PG8_LDB(B1, 0, 1); PG8_STAGE(PG8_SB(0, 0), b2, voffB);
            PG8_BAR; PG8_WAIT_L(0); PG8_MMA(0, 1, At, B1); PG8_BAR;
            PG8_LDA(At, 0, 1); PG8_STAGE(PG8_SA(0, 0), a2, voffA);
            PG8_BAR; PG8_WAIT_L(0); PG8_MMA(1, 0, At, B0); PG8_BAR; PG8_SCHED;
            PG8_STAGE(PG8_SB(0, 1), b2 + hstepB, voffB);
            PG8_WAIT_V(6); PG8_BAR; PG8_MMA(1, 1, At, B1); PG8_BAR;
            PG8_LDB(B0, 1, 0); PG8_SCHED; PG8_LDA(At, 1, 0); PG8_STAGE(PG8_SA(0, 1), a2 + hstepA, voffA);
            PG8_WAIT_L(8); PG8_BAR; PG8_WAIT_L(0); PG8_MMA(0, 0, At, B0); PG8_BAR; PG8_SCHED;
            PG8_LDB(B1, 1, 1); PG8_STAGE(PG8_SB(1, 0), b3, voffB);
            PG8_BAR; PG8_WAIT_L(0); PG8_MMA(0, 1, At, B1); PG8_BAR;
            PG8_LDA(At, 1, 1); PG8_STAGE(PG8_SA(1, 0), a3, voffA);
            PG8_BAR; PG8_WAIT_L(0); PG8_MMA(1, 0, At, B0); PG8_BAR; PG8_SCHED;
            PG8_STAGE(PG8_SB(1, 1), b3 + hstepB, voffB);
            PG8_WAIT_V(6); PG8_BAR; PG8_MMA(1, 1, At, B1); PG8_BAR;
            }
        }
        if constexpr (ALIGN_EPI) { if (wr == 0) PG8_BAR; }
        if constexpr (!Epi::AFTER_DRAIN) { E(acc, cur, wr, wc, fr, fq); S.done(cur); }
        if (!has_next) break;
#pragma unroll
        for (int a = 0; a < 2; ++a)
#pragma unroll
            for (int b = 0; b < 2; ++b)
#pragma unroll
                for (int m = 0; m < 4; ++m)
#pragma unroll
                    for (int n = 0; n < 2; ++n) acc[a][b][m][n] = (f32x4){0.f, 0.f, 0.f, 0.f};
        cur = nxt; cA = nA; cB = nB; ++ui;
        if constexpr (ALIGN_EPI) { if (wr == 1) PG8_BAR; }
    }
    PG8_WAIT_V(0);
    if constexpr (!ALIGN_EPI) { if (wr == 0) PG8_BAR; }
    PG8_BAR;
    if constexpr (Epi::AFTER_DRAIN) { E.fused(acc, cur, wr, wc, fr, fq, lds, wid, lane); S.done(cur); }
#undef PG8_SA
#undef PG8_SB
#undef PG8_STAGE
#undef PG8_LDA
#undef PG8_LDB
#undef PG8_MMA
#undef PG8_WAIT_V
#undef PG8_WAIT_L
#undef PG8_BAR
#undef PG8_SCHED
}
}

namespace att {
#define ALAS __attribute__((address_space(3)))
typedef unsigned short bf16;
typedef short bf16x8 __attribute__((ext_vector_type(8)));
typedef short s16x4 __attribute__((ext_vector_type(4)));
typedef float f32x16 __attribute__((ext_vector_type(16)));
typedef float f32x4 __attribute__((ext_vector_type(4)));
typedef unsigned u32x4 __attribute__((ext_vector_type(4)));
typedef unsigned u32x2 __attribute__((ext_vector_type(2)));
typedef ALAS const char* lcp;
constexpr float NEGF = -1e30f;
constexpr float C2 = 0.125f * 1.4426950408889634f;
__device__ __forceinline__ int crow(int r, int hi) { return (r & 3) + 8 * (r >> 2) + 4 * hi; }
__device__ __forceinline__ void glds16(const void* gsrc, unsigned lds_dst) { unsigned keep;
    asm volatile("s_mov_b32 %0, m0\n\ts_mov_b32 m0, %2\n\ts_nop 0\n\tglobal_load_lds_dwordx4 %1, off\n\ts_mov_b32 m0, %0" : "=&s"(keep) : "v"(gsrc), "s"(lds_dst) : "memory"); }
typedef float f32x2_t __attribute__((ext_vector_type(2))); typedef __bf16 bf16x2_t __attribute__((ext_vector_type(2)));
__device__ __forceinline__ unsigned cvtpk(float lo, float hi) { f32x2_t v = {lo, hi}; bf16x2_t b = __builtin_convertvector(v, bf16x2_t); return __builtin_bit_cast(unsigned, b); }
__device__ __forceinline__ float ex2(float x) { return __builtin_amdgcn_exp2f(x); }
__device__ __forceinline__ float bf2f(unsigned short h) { return __uint_as_float((unsigned)h << 16); }
__device__ __forceinline__ void qkt(f32x16& p0, f32x16& p1, lcp Kslot, const bf16x8* qr, int r32, int hi) {
    lcp kb = Kslot + hi * 1024 + r32 * 16;
    f32x16 z = {};
#pragma unroll
    for (int d0 = 0; d0 < 4; ++d0) {
        const bf16x8 b0 = *(const ALAS bf16x8*)(kb + d0 * 2048);
        const bf16x8 b1 = *(const ALAS bf16x8*)(kb + d0 * 2048 + 512);
        if (d0 == 0) { p0 = __builtin_amdgcn_mfma_f32_32x32x16_bf16(b0, qr[0], z, 0, 0, 0); p1 = __builtin_amdgcn_mfma_f32_32x32x16_bf16(b1, qr[0], z, 0, 0, 0); }
        else { p0 = __builtin_amdgcn_mfma_f32_32x32x16_bf16(b0, qr[d0], p0, 0, 0, 0); p1 = __builtin_amdgcn_mfma_f32_32x32x16_bf16(b1, qr[d0], p1, 0, 0, 0); } }
}
__device__ __forceinline__ void pv(f32x16* o, int vb, bf16x8 pa0, bf16x8 pa1, bf16x8 pa2, bf16x8 pa3) {
#pragma unroll
    for (int d0 = 0; d0 < 2; ++d0) { s16x4 lo[4], hi[4];
#pragma unroll
        for (int ks = 0; ks < 4; ++ks) {
            asm volatile("ds_read_b64_tr_b16 %0,%1 offset:%c2" : "=&v"(lo[ks]) : "v"(vb), "i"(d0 * 4096 + ks * 1024) : "memory");
            asm volatile("ds_read_b64_tr_b16 %0,%1 offset:%c2" : "=&v"(hi[ks]) : "v"(vb), "i"(d0 * 4096 + ks * 1024 + 512) : "memory"); }
        asm volatile("s_waitcnt lgkmcnt(0)" ::: "memory"); __builtin_amdgcn_sched_barrier(0);
#define ATT_PK(k) (bf16x8){lo[k][0], lo[k][1], lo[k][2], lo[k][3], hi[k][0], hi[k][1], hi[k][2], hi[k][3]}
        o[d0] = __builtin_amdgcn_mfma_f32_32x32x16_bf16(pa0, ATT_PK(0), o[d0], 0, 0, 0);
        o[d0] = __builtin_amdgcn_mfma_f32_32x32x16_bf16(pa1, ATT_PK(1), o[d0], 0, 0, 0);
        o[d0] = __builtin_amdgcn_mfma_f32_32x32x16_bf16(pa2, ATT_PK(2), o[d0], 0, 0, 0);
        o[d0] = __builtin_amdgcn_mfma_f32_32x32x16_bf16(pa3, ATT_PK(3), o[d0], 0, 0, 0);
#undef ATT_PK
    }
}
__device__ __forceinline__ int vbase(unsigned vslot, int lane) { const int hi = lane >> 5; return (int)vslot + ((lane >> 4) & 1) * 32 + (lane & 3) * 8 + (4 * hi + ((lane & 15) >> 2)) * 64; }
__device__ __forceinline__ float swap_max(float m) { auto rr = __builtin_amdgcn_permlane32_swap(__float_as_uint(m), __float_as_uint(m), false, false); return fmaxf(__uint_as_float(rr[0]), __uint_as_float(rr[1])); }
__device__ __forceinline__ float swap_sum(float m) { auto rr = __builtin_amdgcn_permlane32_swap(__float_as_uint(m), __float_as_uint(m), false, false); return __uint_as_float(rr[0]) + __uint_as_float(rr[1]); }
__device__ __forceinline__ float rowmax(const f32x16& p0, const f32x16& p1) {
    float a = fmaxf(p0[0], p1[0]);
#pragma unroll
    for (int r = 1; r < 16; ++r) a = fmaxf(a, fmaxf(p0[r], p1[r]));
    return swap_max(a);
}
struct Soft { float m, l; f32x16 o[2]; };
__device__ __forceinline__ void soft_init(Soft& s) { s.m = NEGF; s.l = 0.f; s.o[0] = (f32x16){}; s.o[1] = (f32x16){}; }
__device__ __forceinline__ void soft_step(Soft& s, f32x16& p0, f32x16& p1, ALAS float* wsf, int vb, int r32, int hi) {
    const float mx = rowmax(p0, p1), mnew = fmaxf(s.m, mx);
    if (__any(mnew > s.m)) {
        const float f = ex2(s.m - mnew); s.l *= f; s.m = mnew;
        if (hi == 0) wsf[r32] = f;
#pragma unroll
        for (int r = 0; r < 16; ++r) { const float fr_ = wsf[crow(r, hi)]; s.o[0][r] *= fr_; s.o[1][r] *= fr_; }
    }
    float sum = 0.f;
#pragma unroll
    for (int r = 0; r < 16; ++r) { p0[r] = ex2(p0[r] - s.m); p1[r] = ex2(p1[r] - s.m); sum += p0[r] + p1[r]; }
    s.l += sum;
    const u32x4 pw0 = {cvtpk(p0[0], p0[1]), cvtpk(p0[2], p0[3]), cvtpk(p0[4], p0[5]), cvtpk(p0[6], p0[7])};
    const u32x4 pw1 = {cvtpk(p0[8], p0[9]), cvtpk(p0[10], p0[11]), cvtpk(p0[12], p0[13]), cvtpk(p0[14], p0[15])};
    const u32x4 pw2 = {cvtpk(p1[0], p1[1]), cvtpk(p1[2], p1[3]), cvtpk(p1[4], p1[5]), cvtpk(p1[6], p1[7])};
    const u32x4 pw3 = {cvtpk(p1[8], p1[9]), cvtpk(p1[10], p1[11]), cvtpk(p1[12], p1[13]), cvtpk(p1[14], p1[15])};
    pv(s.o, vb, __builtin_bit_cast(bf16x8, pw0), __builtin_bit_cast(bf16x8, pw1), __builtin_bit_cast(bf16x8, pw2), __builtin_bit_cast(bf16x8, pw3));
}
__device__ __forceinline__ void pv_probs(f32x16* o, const f32x16& p0, const f32x16& p1, int vb) {
    const u32x4 pw0 = {cvtpk(p0[0], p0[1]), cvtpk(p0[2], p0[3]), cvtpk(p0[4], p0[5]), cvtpk(p0[6], p0[7])};
    const u32x4 pw1 = {cvtpk(p0[8], p0[9]), cvtpk(p0[10], p0[11]), cvtpk(p0[12], p0[13]), cvtpk(p0[14], p0[15])};
    const u32x4 pw2 = {cvtpk(p1[0], p1[1]), cvtpk(p1[2], p1[3]), cvtpk(p1[4], p1[5]), cvtpk(p1[6], p1[7])};
    const u32x4 pw3 = {cvtpk(p1[8], p1[9]), cvtpk(p1[10], p1[11]), cvtpk(p1[12], p1[13]), cvtpk(p1[14], p1[15])};
    pv(o, vb, __builtin_bit_cast(bf16x8, pw0), __builtin_bit_cast(bf16x8, pw1), __builtin_bit_cast(bf16x8, pw2), __builtin_bit_cast(bf16x8, pw3));
}
__device__ __forceinline__ void dma_k(const bf16* Kt  , int P, unsigned slot, int wid, int lane) {
    glds16(Kt + (size_t)lane * P + wid * 8, (unsigned)__builtin_amdgcn_readfirstlane(slot + wid * 1024)); }
__device__ __forceinline__ void dma_v(const bf16* Vt, int P, unsigned slot, int wid, int lane) {
    glds16(Vt + (size_t)(16 * (wid & 3) + (lane >> 2)) * P + (wid >> 2) * 32 + (lane & 3) * 8, (unsigned)__builtin_amdgcn_readfirstlane(slot + wid * 1024)); }
__device__ __forceinline__ void dma_k_wave(const bf16* Kt, int P, unsigned slot, int lane) {
#pragma unroll
    for (int c = 0; c < 8; ++c) glds16(Kt + (size_t)lane * P + c * 8, (unsigned)__builtin_amdgcn_readfirstlane(slot + c * 1024)); }
__device__ __forceinline__ void dma_v_wave(const bf16* Vt, int P, unsigned slot, int lane) {
#pragma unroll
    for (int c = 0; c < 8; ++c) glds16(Vt + (size_t)(16 * (c & 3) + (lane >> 2)) * P + (c >> 2) * 32 + (lane & 3) * 8, (unsigned)__builtin_amdgcn_readfirstlane(slot + c * 1024)); }
#define ATT_VMWAIT() asm volatile("s_waitcnt vmcnt(0)" ::: "memory")
constexpr int A_KS = 0, A_VS = 16384, A_STG = 32768, A_S4 = 65536, A_E = 98304, A_WSF = 131072, A_OCS = 133120, A_SELM = 141312, A_S4S = 141376, A_ES = 143424, A_END = 145472;

__device__ __forceinline__ void prompt_selwin_unit(int b, int h, int qb, const bf16* Qb, const bf16* KVb, const float* G, const unsigned* SEL, bf16* Ob, ALAS char* lds) {
    int tid = threadIdx.x; asm volatile("" : "+v"(tid)); const int lane = tid & 63, r32 = lane & 31, hi = lane >> 5, wid = __builtin_amdgcn_readfirstlane(tid >> 6);
    const int g = h >> 2, q0 = qb * 256, qw = q0 + wid * 32, q = qw + r32;
    const size_t m = (size_t)b * 8192 + q;
    const unsigned lds0 = (unsigned)(uintptr_t)lds;
    ALAS float* wsf = (ALAS float*)(lds + A_WSF + wid * 256);
    bf16x8 qr[4];
#pragma unroll
    for (int d0 = 0; d0 < 4; ++d0) qr[d0] = *(const bf16x8*)(Qb + m * 1024 + h * 64 + d0 * 16 + hi * 8);
    const u32x4 selw = *(const u32x4*)(SEL + ((size_t)(b * 4 + g) * 8192 + q) * 4);
    const float g1 = G[m * 48 + h * 3 + 1], g2 = G[m * 48 + h * 3 + 2];
    f32x16 oacc[2]; oacc[0] = (f32x16){}; oacc[1] = (f32x16){};
    const bf16* KV0 = KVb + (size_t)b * 8192 * 1536;
    for (int br = 0; br < 2; ++br) {
        const int kcol = (br == 0 ? 1024 : 512) + g * 64, vcol = kcol + 256;
        const int t_lo = br == 0 ? (q0 > 511 ? (q0 - 511) >> 6 : 0) : 0, t_hi = (q0 + 255) >> 6;
        Soft s; soft_init(s);
        __syncthreads();
        dma_k(KV0 + (size_t)t_lo * 64 * 1536 + kcol, 1536, lds0 + A_KS, wid, lane); dma_v(KV0 + (size_t)t_lo * 64 * 1536 + vcol, 1536, lds0 + A_VS, wid, lane);
        for (int t = t_lo; t <= t_hi; ++t) {
            const int sl = (t - t_lo) & 1;
            ATT_VMWAIT(); __syncthreads();
            if (t < t_hi) { dma_k(KV0 + (size_t)(t + 1) * 64 * 1536 + kcol, 1536, lds0 + A_KS + (sl ^ 1) * 8192, wid, lane); dma_v(KV0 + (size_t)(t + 1) * 64 * 1536 + vcol, 1536, lds0 + A_VS + (sl ^ 1) * 8192, wid, lane); }
            const int k0 = t * 64;
            const bool need = br == 0 ? (k0 + 63 >= qw - 511 && k0 <= qw + 31) : (k0 <= qw + 31);
            if (need) {
                f32x16 p0, p1; qkt(p0, p1, (lcp)(lds + A_KS + sl * 8192), qr, r32, hi);
                if (br == 0) {
#pragma unroll
                    for (int r = 0; r < 16; ++r) { const int kv = k0 + crow(r, hi);
                        if (!(kv <= q && kv > q - 512)) p0[r] = NEGF;
                        if (!(kv + 32 <= q && kv + 32 > q - 512)) p1[r] = NEGF; }
                } else {
                    const unsigned w = t < 32 ? selw.x : t < 64 ? selw.y : t < 96 ? selw.z : selw.w;
                    const bool bit = (w >> (t & 31)) & 1u;
#pragma unroll
                    for (int r = 0; r < 16; ++r) { const int kv = k0 + crow(r, hi);
                        if (!bit || kv > q) p0[r] = NEGF;
                        if (!bit || kv + 32 > q) p1[r] = NEGF; }
                }
                soft_step(s, p0, p1, wsf, vbase(lds0 + A_VS + sl * 8192, lane), r32, hi);
            }
        }
        const float lt = swap_sum(s.l), sc = (br == 0 ? g2 : g1) / lt;
        if (hi == 0) wsf[r32] = sc;
#pragma unroll
        for (int r = 0; r < 16; ++r) { const float f = wsf[crow(r, hi)]; oacc[0][r] += s.o[0][r] * f; oacc[1][r] += s.o[1][r] * f; }
    }
    ALAS float* stg = (ALAS float*)(lds + A_STG + wid * 8192);
#pragma unroll
    for (int r = 0; r < 16; ++r) { const int orow = crow(r, hi); stg[orow * 64 + r32] = oacc[0][r]; stg[orow * 64 + 32 + r32] = oacc[1][r]; }
#pragma unroll
    for (int i = 0; i < 4; ++i) { const int row = i * 8 + (lane >> 3), ch = lane & 7;
        const f32x4 a = *(ALAS f32x4*)(stg + row * 64 + ch * 8), c = *(ALAS f32x4*)(stg + row * 64 + ch * 8 + 4);
        bf16* op = Ob + ((size_t)b * 8192 + qw + row) * 1024 + h * 64 + ch * 8;
        const u32x4 old = *(const u32x4*)op; u32x4 nw;
        nw.x = cvtpk(a[0] + __uint_as_float(old.x << 16), a[1] + __uint_as_float(old.x & 0xffff0000u));
        nw.y = cvtpk(a[2] + __uint_as_float(old.y << 16), a[3] + __uint_as_float(old.y & 0xffff0000u));
        nw.z = cvtpk(c[0] + __uint_as_float(old.z << 16), c[1] + __uint_as_float(old.z & 0xffff0000u));
        nw.w = cvtpk(c[2] + __uint_as_float(old.w << 16), c[3] + __uint_as_float(old.w & 0xffff0000u));
        *(u32x4*)op = nw; }
}

__device__ __forceinline__ float headsum(float v) { v += __shfl_xor(v, 8); v += __shfl_xor(v, 16); return v; }
__device__ __forceinline__ void imp_store(const f32x16& p0, const f32x16& p1, int t, int hi, int hl, int qi, ALAS float* S4, ALAS float* E, int stride, int jmax) {
#pragma unroll
    for (int a = 0; a < 4; ++a) {
        const float s0 = headsum((p0[4 * a] + p0[4 * a + 1]) + (p0[4 * a + 2] + p0[4 * a + 3])), e0 = headsum(p0[4 * a + 3]);
        const float s1 = headsum((p1[4 * a] + p1[4 * a + 1]) + (p1[4 * a + 2] + p1[4 * a + 3])), e1 = headsum(p1[4 * a + 3]);
        if (hl == 0) { const int j = 16 * t + 2 * a + hi;
            S4[qi * stride + j] = s0; if (j + 1 <= jmax) E[qi * stride + j + 1] = e0;
            S4[qi * stride + j + 8] = s1; if (j + 9 <= jmax) E[qi * stride + j + 9] = e1; }
    }
}
__device__ __forceinline__ void topk_row(ALAS float* v, const ALAS float* e, int cur, int lane, unsigned long long& ma, unsigned long long& mb, bool two) {
    const int ja = lane, jb = lane + 64;
    const float fa = ja <= cur ? v[ja] + e[ja] + ((ja == 0 || ja == cur || ja == cur - 1) ? 1e4f : 0.f) : NEGF;
    float fb = NEGF;
    if (two) fb = jb <= cur ? v[jb] + e[jb] + ((jb == cur || jb == cur - 1) ? 1e4f : 0.f) : NEGF;
    v[ja] = fa; if (two) v[jb] = fb;
    int ca = 0, cb = 0;
    for (int j4 = 0; j4 <= (cur >> 2); ++j4) { const f32x4 x = *(const ALAS f32x4*)(v + 4 * j4);
#pragma unroll
        for (int i = 0; i < 4; ++i) { const int jj = 4 * j4 + i;
            ca += (x[i] > fa || (x[i] == fa && jj < ja)) ? 1 : 0;
            cb += (x[i] > fb || (x[i] == fb && jj < jb)) ? 1 : 0; } }
    ma = __ballot(ja <= cur && ca < 16);
    mb = two ? __ballot(jb <= cur && cb < 16) : 0ull;
}

__device__ __forceinline__ void prompt_cmp_unit(int b, int g, int qt, const bf16* Qb, const bf16* KCp, const float* G, unsigned* SEL, bf16* Ob, ALAS char* lds) {
    int tid = threadIdx.x; asm volatile("" : "+v"(tid)); const int lane = tid & 63, r32 = lane & 31, hi = lane >> 5, wid = __builtin_amdgcn_readfirstlane(tid >> 6);
    const int qi = r32 & 7, hl = r32 >> 3, q0 = qt * 64, q = q0 + 8 * wid + qi, h = 4 * g + hl;
    const size_t m = (size_t)b * 8192 + q;
    const unsigned lds0 = (unsigned)(uintptr_t)lds;
    ALAS float* wsf = (ALAS float*)(lds + A_WSF + wid * 256);
    ALAS float* S4 = (ALAS float*)(lds + A_S4 + wid * 4096); ALAS float* E = (ALAS float*)(lds + A_E + wid * 4096);
    bf16x8 qr[4];
#pragma unroll
    for (int d0 = 0; d0 < 4; ++d0) qr[d0] = *(const bf16x8*)(Qb + m * 1024 + h * 64 + d0 * 16 + hi * 8);
    const bf16* Kc = KCp + (size_t)(b * 4 + g) * 512 * 64; const bf16* Vc = KCp + (size_t)(8 + b * 4 + g) * 512 * 64;
    const int ntile = ((q0 + 32) >> 10) + 1, nsteps = 2 * ntile;
    const int nlim = q >= 31 ? ((q - 31) >> 4) : -1;
    float mrun = NEGF, l = 0.f, linv = 0.f;
    f32x16 o[2]; o[0] = (f32x16){}; o[1] = (f32x16){};
    __syncthreads();
    if (lane < 8) E[lane * 128] = 0.f;
    dma_k(Kc, 64, lds0 + A_KS, wid, lane);
    for (int s = 0; s < nsteps; ++s) {
        const int pass = s >= ntile ? 1 : 0, t = pass ? s - ntile : s, sl = s & 1;
        ATT_VMWAIT(); __syncthreads();
        if (s + 1 < nsteps) { const int p2 = (s + 1) >= ntile ? 1 : 0, t2 = p2 ? s + 1 - ntile : s + 1;
            dma_k(Kc + (size_t)t2 * 4096, 64, lds0 + A_KS + (sl ^ 1) * 8192, wid, lane);
            if (p2) dma_v(Vc + (size_t)t2 * 4096, 64, lds0 + A_VS + (sl ^ 1) * 8192, wid, lane); }
        f32x16 p0, p1; qkt(p0, p1, (lcp)(lds + A_KS + sl * 8192), qr, r32, hi);
        const int n0 = t * 64;
        if (!pass) {
#pragma unroll
            for (int r = 0; r < 16; ++r) { const int n = n0 + crow(r, hi); if (n > nlim) p0[r] = NEGF; if (n + 32 > nlim) p1[r] = NEGF; }
            const float mx = rowmax(p0, p1), mnew = fmaxf(mrun, mx);
            float sum = 0.f;
#pragma unroll
            for (int r = 0; r < 16; ++r) sum += ex2(p0[r] - mnew) + ex2(p1[r] - mnew);
            l = l * ex2(mrun - mnew) + sum; mrun = mnew;
            if (s == ntile - 1) linv = 1.f / swap_sum(l);
        } else {
#pragma unroll
            for (int r = 0; r < 16; ++r) { const int n = n0 + crow(r, hi);
                p0[r] = n <= nlim ? ex2(p0[r] - mrun) * linv : 0.f;
                p1[r] = n + 32 <= nlim ? ex2(p1[r] - mrun) * linv : 0.f; }
            imp_store(p0, p1, t, hi, hl, qi, S4, E, 128, 127);
            pv_probs(o, p0, p1, vbase(lds0 + A_VS + sl * 8192, lane));
        }
    }
    { const float g0 = G[m * 48 + h * 3];
      if (hi == 0) wsf[r32] = g0;
      ALAS bf16* stg = (ALAS bf16*)(lds + A_STG + wid * 4096);
#pragma unroll
      for (int r = 0; r < 16; ++r) { const int orow = crow(r, hi); const float f = wsf[orow];
          stg[orow * 64 + r32] = (bf16)(cvtpk(o[0][r] * f, 0.f) & 0xffffu); stg[orow * 64 + 32 + r32] = (bf16)(cvtpk(o[1][r] * f, 0.f) & 0xffffu); }
#pragma unroll
      for (int i = 0; i < 4; ++i) { const int idx = i * 64 + lane, row = idx >> 3, ch = idx & 7;
          const u32x4 v = *(const ALAS u32x4*)(stg + row * 64 + ch * 8);
          *(u32x4*)(Ob + ((size_t)b * 8192 + q0 + 8 * wid + (row & 7)) * 1024 + (4 * g + (row >> 3)) * 64 + ch * 8) = v; } }
    for (int qq = 0; qq < 8; ++qq) {
        unsigned long long ma, mb; topk_row(S4 + qq * 128, E + qq * 128, qt, lane, ma, mb, true);
        if (lane == 0) { u32x4 w = {(unsigned)ma, (unsigned)(ma >> 32), (unsigned)mb, (unsigned)(mb >> 32)};
            *(u32x4*)(SEL + ((size_t)(b * 4 + g) * 8192 + q0 + 8 * wid + qq) * 4) = w; }
    }
}

__device__ __forceinline__ void stage_tile(ALAS char* ks, ALAS char* vs, const float* base, int rstride, int nvalid, int lane) {
    const int rsub = lane >> 4, c16 = lane & 15;
    const float* p = base + (size_t)rsub * rstride + 4 * c16;
#pragma unroll 1
    for (int i0 = 0; i0 < 16; i0 += 2) {
        f32x4 kx[2], vx[2];
#pragma unroll
        for (int j = 0; j < 2; ++j) { const int r = 4 * (i0 + j) + rsub; const bool ok = r < nvalid;
            kx[j] = ok ? *(const f32x4*)(p + (size_t)(4 * (i0 + j)) * rstride) : (f32x4){0.f, 0.f, 0.f, 0.f};
            vx[j] = ok ? *(const f32x4*)(p + (size_t)(4 * (i0 + j)) * rstride + 256) : (f32x4){0.f, 0.f, 0.f, 0.f}; }
#pragma unroll
        for (int j = 0; j < 2; ++j) { const int r = 4 * (i0 + j) + rsub;
            u32x2 kw = {cvtpk(kx[j][0], kx[j][1]), cvtpk(kx[j][2], kx[j][3])}, vw = {cvtpk(vx[j][0], vx[j][1]), cvtpk(vx[j][2], vx[j][3])};
            *(ALAS u32x2*)(ks + (c16 >> 1) * 1024 + r * 16 + (c16 & 1) * 8) = kw;
            *(ALAS u32x2*)(vs + (c16 >> 3) * 4096 + (r >> 4) * 1024 + (r & 15) * 64 + (c16 & 7) * 8) = vw; }
    }
}
__device__ __forceinline__ f32x4 ld_bf4(const bf16* p) { const u32x2 w = *(const u32x2*)p; return (f32x4){__uint_as_float(w.x << 16), __uint_as_float(w.x & 0xffff0000u), __uint_as_float(w.y << 16), __uint_as_float(w.y & 0xffff0000u)}; }

struct SampleIn { const bf16* Qb; const float* kvs; const float* wins; const bf16* KCs; const float* G; const float* cache; const int* ptab; const float* swin; bf16* Ob; };

__device__ __forceinline__ void sample_unit(int bs, int g, const SampleIn& I, ALAS char* lds) {
    int tid = threadIdx.x; asm volatile("" : "+v"(tid)); const int lane = tid & 63, r32 = lane & 31, hi = lane >> 5, wid = __builtin_amdgcn_readfirstlane(tid >> 6);
    const int qi = r32 & 7, hl = r32 >> 3, h = 4 * g + hl;
    const size_t m = (size_t)16384 + bs * 8 + qi;
    const unsigned lds0 = (unsigned)(uintptr_t)lds;
    ALAS char* ksp = lds + wid * 16384; ALAS char* vsp = ksp + 8192;
    const unsigned KS = lds0 + wid * 16384, VS = KS + 8192;
    ALAS float* wsf = (ALAS float*)(lds + A_WSF + wid * 256);
    ALAS float* OCS = (ALAS float*)(lds + A_OCS);
    ALAS unsigned long long* SELM = (ALAS unsigned long long*)(lds + A_SELM);
    bf16x8 qr[4];
#pragma unroll
    for (int d0 = 0; d0 < 4; ++d0) qr[d0] = *(const bf16x8*)(I.Qb + m * 1024 + h * 64 + d0 * 16 + hi * 8);
    const float g0 = I.G[m * 48 + h * 3], g1 = I.G[m * 48 + h * 3 + 1], g2 = I.G[m * 48 + h * 3 + 2];
    __syncthreads();
    if (wid == 0) {
        ALAS float* S4 = (ALAS float*)(lds + A_S4S); ALAS float* E = (ALAS float*)(lds + A_ES);
        const bf16* Kc = I.KCs + (size_t)(bs * 4 + g) * 128 * 64; const bf16* Vc = I.KCs + (size_t)(512 + bs * 4 + g) * 128 * 64;
        dma_k_wave(Kc, 64, KS, lane); dma_k_wave(Kc + 4096, 64, VS, lane);
        if (lane < 8) { E[lane * 64] = 0.f; S4[lane * 64 + 32] = 0.f; }
        ATT_VMWAIT();
        f32x16 a0, a1, b0, b1; qkt(a0, a1, (lcp)ksp, qr, r32, hi); qkt(b0, b1, (lcp)vsp, qr, r32, hi);
#pragma unroll
        for (int r = 0; r < 16; ++r) if (96 + crow(r, hi) > 126) b1[r] = NEGF;
        const float mx = fmaxf(rowmax(a0, a1), rowmax(b0, b1));
        float sum = 0.f;
#pragma unroll
        for (int r = 0; r < 16; ++r) { a0[r] = ex2(a0[r] - mx); a1[r] = ex2(a1[r] - mx); b0[r] = ex2(b0[r] - mx); b1[r] = (96 + crow(r, hi) > 126) ? 0.f : ex2(b1[r] - mx); sum += (a0[r] + a1[r]) + (b0[r] + b1[r]); }
        const float inv = 1.f / swap_sum(sum);
#pragma unroll
        for (int r = 0; r < 16; ++r) { a0[r] *= inv; a1[r] *= inv; b0[r] *= inv; b1[r] *= inv; }
        imp_store(a0, a1, 0, hi, hl, qi, S4, E, 64, 63); imp_store(b0, b1, 1, hi, hl, qi, S4, E, 64, 63);
        asm volatile("s_waitcnt lgkmcnt(0)" ::: "memory");
        dma_v_wave(Vc, 64, KS, lane); dma_v_wave(Vc + 4096, 64, VS, lane); ATT_VMWAIT();
        f32x16 o[2]; o[0] = (f32x16){}; o[1] = (f32x16){};
        pv_probs(o, a0, a1, vbase(KS, lane)); pv_probs(o, b0, b1, vbase(VS, lane));
        if (hi == 0) wsf[r32] = g0;
#pragma unroll
        for (int r = 0; r < 16; ++r) { const int orow = crow(r, hi); const float f = wsf[orow]; OCS[orow * 64 + r32] = o[0][r] * f; OCS[orow * 64 + 32 + r32] = o[1][r] * f; }
        for (int qq = 0; qq < 8; ++qq) { unsigned long long ma, mb; topk_row(S4 + qq * 64, E + qq * 64, 32, lane, ma, mb, false); if (lane == 0) SELM[qq] = ma; }
    }
    __syncthreads();
    const unsigned long long sm = SELM[qi];
    const int row = tid >> 4, c4 = (tid & 15) * 4;
    f32x4 out4 = *(ALAS f32x4*)(OCS + row * 64 + c4);
    const size_t mrow = (size_t)16384 + bs * 8 + (row & 7); const int hrow = 4 * g + (row >> 3);
#pragma nounroll
    for (int br = 0; br < 2; ++br) {
        Soft s; soft_init(s);
        const int ntl = br == 0 ? 33 : 9;
#pragma nounroll
        for (int t = wid; t < ntl; t += 8) {
            if (br == 0 && !__any((int)((sm >> t) & 1ull))) continue;
            const float* base; int rstride, nvalid = 64;
            if (br == 0) { rstride = 1024;
                if (t < 32) { const int page = I.ptab[bs * 16 + (t >> 1)]; base = I.cache + ((size_t)(page * 128 + (t & 1) * 64) * 16 + 8 + g) * 64; }
                else { base = I.kvs + (size_t)bs * 8 * 1024 + 512 + g * 64; nvalid = 8; } }
            else { rstride = 512;
                if (t < 8) base = I.swin + ((size_t)(bs * 512 + t * 64) * 8 + g) * 64;
                else { base = I.wins + ((size_t)bs * 512 + 504) * 512 + g * 64; nvalid = 8; } }
            stage_tile(ksp, vsp, base, rstride, nvalid, lane);
            f32x16 p0, p1; qkt(p0, p1, (lcp)ksp, qr, r32, hi);
            if (br == 0) {
                const bool bit = (sm >> t) & 1ull;
#pragma unroll
                for (int r = 0; r < 16; ++r) { const int kk = crow(r, hi);
                    if (!bit || (t == 32 && kk > qi)) p0[r] = NEGF;
                    if (!bit || t == 32) p1[r] = NEGF; }
            } else {
#pragma unroll
                for (int r = 0; r < 16; ++r) { const int i0 = t * 64 + crow(r, hi), i1 = i0 + 32;
                    if (!(i0 > qi && i0 <= 512 + qi)) p0[r] = NEGF;
                    if (!(i1 > qi && i1 <= 512 + qi)) p1[r] = NEGF; }
            }
            soft_step(s, p0, p1, wsf, vbase(VS, lane), r32, hi);
        }
        { ALAS float* PO = (ALAS float*)ksp; ALAS float* PM = (ALAS float*)vsp; ALAS float* PL = PM + 32;
          const float lt = swap_sum(s.l);
          asm volatile("s_waitcnt lgkmcnt(0)" ::: "memory");
          if (hi == 0) { PM[r32] = s.m; PL[r32] = lt; }
#pragma unroll
          for (int r = 0; r < 16; ++r) { const int orow = crow(r, hi); PO[orow * 64 + r32] = s.o[0][r]; PO[orow * 64 + 32 + r32] = s.o[1][r]; } }
        __syncthreads();
        { float M = NEGF;
#pragma unroll
          for (int w = 0; w < 8; ++w) M = fmaxf(M, *(ALAS float*)(lds + w * 16384 + 8192 + row * 4));
          float L = 0.f; f32x4 acc = {0.f, 0.f, 0.f, 0.f};
#pragma unroll
          for (int w = 0; w < 8; ++w) { const float f = ex2(*(ALAS float*)(lds + w * 16384 + 8192 + row * 4) - M);
              L += *(ALAS float*)(lds + w * 16384 + 8192 + 128 + row * 4) * f; acc += *(ALAS f32x4*)(lds + w * 16384 + (row * 64 + c4) * 4) * f; }
          const float gt = I.G[mrow * 48 + hrow * 3 + (br == 0 ? 1 : 2)];
          out4 += acc * (gt / L); }
        __syncthreads();
    }
    { u32x2 w = {cvtpk(out4[0], out4[1]), cvtpk(out4[2], out4[3])}; *(u32x2*)(I.Ob + mrow * 1024 + hrow * 64 + c4) = w; }
    (void)g1; (void)g2;
}
#undef ALAS
}

constexpr int DM = 1024, SEQ = 8192, MP = 16384, MS = 1024, MT = MP + MS;
constexpr int FF = 2816, F2 = 5632, NKVC = 1536, NQG = 1072, NQGP = 1280, NADA = 24576;
constexpr int RCMP = 69632;
constexpr float LN_EPS = 1e-5f, DN_ALPHA = 1.681792830507429f;
constexpr size_t O_YP = 0, O_YS = 16777216, O_KVP = 17825792, O_KVS = 34603008, O_WINP = 35651584, O_WINS = 36175872, O_POOLP = 69730304, O_POOLS = 69791744, O_CONVP = 73723904, O_CONVS = 73814016, O_END = 79581184;
constexpr size_t MiB = 1u << 20;
constexpr size_t WS_CTL = 0, CTL_ZERO_BYTES = 1 * MiB;
constexpr size_t WS_ADAT = 2 * MiB, WS_WUP = 50 * MiB, WS_WDN = 94 * MiB, WS_WKV = 116 * MiB, WS_WQG = 119 * MiB, WS_WO = 124 * MiB, WS_WPOOL = 128 * MiB, WS_W1C = 129 * MiB,
                 WS_SC = 131 * MiB, WS_B1E = 132 * MiB, WS_ADA = 133 * MiB, WS_X = 160 * MiB, WS_F = 228 * MiB, WS_U = 296 * MiB, WS_XB = 330 * MiB, WS_H = 364 * MiB, WS_ACT = 552 * MiB,
                 WS_KVB = 646 * MiB, WS_QB = 698 * MiB, WS_G = 732 * MiB, WS_OB = 736 * MiB, WS_SEL = 770 * MiB, WS_KCP = 772 * MiB, WS_KCS = 774 * MiB, WS_ACMP = 792 * MiB, WS_TB = 1064 * MiB, WS_END = 1200 * MiB;
constexpr int CW_BAR = 4096;
constexpr int RING_OFF = 0, LDSCTL_OFF = 147456, MISC_OFF = LDSCTL_OFF + 320, LDS_BYTES = 151552;
static_assert(att::A_END <= LDSCTL_OFF && pg8::STAGE_BYTES <= LDSCTL_OFF, "LDS map");

#define GAS __attribute__((address_space(1)))
#define LAS __attribute__((address_space(3)))
typedef unsigned short bf16;
typedef unsigned v4u __attribute__((ext_vector_type(4)));
typedef unsigned v2u __attribute__((ext_vector_type(2)));
typedef float f32x4 __attribute__((ext_vector_type(4)));
#define LDS_WAIT() asm volatile("s_waitcnt lgkmcnt(0)" ::: "memory")
__device__ __forceinline__ unsigned f2bf(float f) { unsigned u = __builtin_bit_cast(unsigned, f); return (u + 0x7fffu + ((u >> 16) & 1u)) >> 16; }
__device__ __forceinline__ unsigned pk2(float lo, float hi) { return f2bf(lo) | (f2bf(hi) << 16); }
__device__ __forceinline__ float bflo(unsigned w) { return __uint_as_float(w << 16); }
__device__ __forceinline__ float bfhi(unsigned w) { return __uint_as_float(w & 0xffff0000u); }

#define XB_TMO      128
#define XB_XCNT(j)  (256  + 64 * (j))
#define XB_XSUB(j)  (1280 + 64 * (j))
#define XB_XGEN(j)  (2304 + 64 * (j))
#define XB_TOP      3328
#define XB_TOPGEN   3392
#define XCD_BAR_WORDS 3456
#define XB_SPIN_CAP (1u << 18)

__device__ __forceinline__ unsigned xb_ld(unsigned* p)              { return __hip_atomic_load(p, __ATOMIC_RELAXED, __HIP_MEMORY_SCOPE_AGENT); }
__device__ __forceinline__ unsigned xb_add(unsigned* p, unsigned v) { return __hip_atomic_fetch_add(p, v, __ATOMIC_RELAXED, __HIP_MEMORY_SCOPE_AGENT); }
__device__ __forceinline__ unsigned xb_xcc_id() { return (unsigned)__builtin_amdgcn_s_getreg((3 << 11) | 20) & 0xFu; }
#define XB_SPIN(cond, bar) do { unsigned _sp = 0; while (cond) { __builtin_amdgcn_s_sleep(1); \
    if ((++_sp & 255u) == 0u) { if (xb_ld(&(bar)[XB_TMO])) break; if (_sp > XB_SPIN_CAP) { atomicAdd(&(bar)[XB_TMO], 1u); break; } } } } while (0)

struct XcdBarrier {
    unsigned* bar; unsigned x;
    volatile LAS unsigned* st;
};

__device__ __forceinline__ XcdBarrier xcd_barrier_post(unsigned* bar, volatile LAS unsigned* st) {
    XcdBarrier b; b.bar = bar; b.x = xb_xcc_id(); b.st = st;
    if (threadIdx.x == 0) (void)xb_add(&bar[XB_XCNT(b.x)], 1u);
    return b;
}
__device__ __forceinline__ void xcd_barrier_complete(unsigned* bar, unsigned x, unsigned& nloc, unsigned& nx) {
    const unsigned G = gridDim.x * gridDim.y * gridDim.z;
    unsigned sum, cnt, mine, sp = 0u;
    for (;;) {
        sum = 0u; cnt = 0u; mine = 0u;
#pragma unroll
        for (unsigned j = 0; j < 16; ++j) { const unsigned c = xb_ld(&bar[XB_XCNT(j)]); sum += c; cnt += (c > 0u) ? 1u : 0u; mine = (j == x) ? c : mine; }
        if (sum == G) break;
        __builtin_amdgcn_s_sleep(1);
        if ((++sp & 255u) == 0u) { if (xb_ld(&bar[XB_TMO])) break; if (sp > XB_SPIN_CAP) { atomicAdd(&bar[XB_TMO], 1u); break; } }
    }
    nloc = mine > 0u ? mine : 1u; nx = cnt > 0u ? cnt : 1u;
}

__device__ __forceinline__ void xcd_barrier(const XcdBarrier& b) {
    asm volatile("s_waitcnt vmcnt(0)" ::: "memory");
    __syncthreads();
    if (threadIdx.x == 0) {
        unsigned* bar = b.bar;
        __builtin_amdgcn_s_waitcnt(0);
        unsigned nloc = b.st[0], nx = b.st[1];
        if (nloc == 0u) { xcd_barrier_complete(bar, b.x, nloc, nx); b.st[0] = nloc; b.st[1] = nx; }
        const unsigned old = xb_add(&bar[XB_XSUB(b.x)], 1u);
        const unsigned gen = old / nloc;
        if (old + 1u == (gen + 1u) * nloc) {
            __builtin_amdgcn_fence(__ATOMIC_RELEASE, "agent");
            asm volatile("s_waitcnt vmcnt(0)" ::: "memory");
            const unsigned og = xb_add(&bar[XB_TOP], 1u);
            const unsigned tg = og / nx;
            if (og + 1u == (tg + 1u) * nx) xb_add(&bar[XB_TOPGEN], 1u);
            else XB_SPIN(xb_ld(&bar[XB_TOPGEN]) == tg, bar);
            __builtin_amdgcn_fence(__ATOMIC_ACQUIRE, "agent");
            xb_add(&bar[XB_XGEN(b.x)], 1u);
            asm volatile("s_waitcnt vmcnt(0)" ::: "memory");
        } else {
            XB_SPIN(xb_ld(&bar[XB_XGEN(b.x)]) == gen, bar);
            __builtin_amdgcn_fence(__ATOMIC_ACQUIRE, "agent");
            asm volatile("s_waitcnt vmcnt(0)" ::: "memory");
        }
    }
    __syncthreads();
}

__device__ __forceinline__ float wave_sum(float v) {
#pragma unroll
    for (int o = 1; o < 64; o <<= 1) v += __shfl_xor(v, o);
    return v;
}
__device__ __forceinline__ void transpose_item(const float* W, int K, int N, bf16* WT, int row_off, LAS float* scr, int item, int lane) {
    const int nblk = (N + 31) / 32, kb = item / nblk, nb = item % nblk, k0 = 64 * kb, n0 = 32 * nb;
    const bool cok = n0 + (lane & 31) < N;
#pragma unroll 8
    for (int i = 0; i < 32; ++i) { const int kk = 2 * i + (lane >> 5); scr[kk * 33 + (lane & 31)] = cok ? W[(size_t)(k0 + kk) * N + n0 + (lane & 31)] : 0.f; }
    LDS_WAIT(); asm volatile("" ::: "memory");
    const int c = lane & 7;
#pragma unroll
    for (int j = 0; j < 4; ++j) { const int n = (lane >> 3) + 8 * j; const LAS float* s = scr + (8 * c) * 33 + n;
        v4u o; o.x = pk2(s[0 * 33], s[1 * 33]); o.y = pk2(s[2 * 33], s[3 * 33]); o.z = pk2(s[4 * 33], s[5 * 33]); o.w = pk2(s[6 * 33], s[7 * 33]);
        if (n0 + n < N) *(v4u*)(WT + (size_t)(row_off + n0 + n) * K + k0 + 8 * c) = o; }
    LDS_WAIT(); asm volatile("" ::: "memory");
}
__device__ __forceinline__ float silu_f(float x) { return x / (1.f + __expf(-x)); }
__device__ __forceinline__ float gelu_tanh_f(float x) { const float u = 0.7978845608028654f * (x + 0.044715f * x * x * x); const float e = __expf(2.f * u); const float th = 1.f - 2.f / (e + 1.f); return 0.5f * x * (1.f + th); }

struct Args { const float* in[28]; float* out; unsigned char* ws; int ph_lo, ph_hi; };
enum { I_XP = 0, I_XS, I_CACHE, I_SWIN, I_SPOOL, I_SCONV, I_PTAB, I_CP, I_CS, I_ADAW, I_ADAB, I_LNG, I_LNB, I_POOLW, I_POOLLS, I_WUP, I_BUP, I_WCONV, I_BCONV, I_WDN, I_WKV, I_PE, I_W1, I_B1, I_W2, I_B2, I_WQG, I_WO };

__device__ __forceinline__ void phase_prologue(const Args& a, LAS unsigned char* lds, int vcu, int G) {
    int tid_ = threadIdx.x; asm volatile("" : "+v"(tid_)); const int lane = tid_ & 63, wave = __builtin_amdgcn_readfirstlane(tid_ >> 6); const int gw = vcu * 8 + wave, NGW = G * 8; const size_t gt = (size_t)vcu * 512 + tid_, NT = (size_t)G * 512; const int tid = tid_; (void)lane; (void)gw; (void)NGW; (void)gt; (void)NT;
    unsigned char* ws = a.ws;
    LAS float* scr = (LAS float*)(lds + wave * 16384);
    constexpr int N_ADA = 4 * 3072, N_UP = 4 * 2816, N_DN = 4 * 1408, N_KV = 768, N_QG = 2 * 544, N_O = 2 * 512, N_PW = 8 * 32, N_W1 = 4 * 128;
    constexpr int NITEMS = N_ADA + N_UP + N_DN + N_KV + N_QG + N_O + N_PW + N_W1;
    for (int it = gw; it < NITEMS; it += NGW) {
        int r = it;
        if (r < N_ADA) { const int l = r / 3072; transpose_item(a.in[I_ADAW] + (size_t)l * 1024 * 6144, 1024, 6144, (bf16*)(ws + WS_ADAT), l * 6144, scr, r % 3072, lane); continue; } r -= N_ADA;
        if (r < N_UP) { const int l = r / 2816; transpose_item(a.in[I_WUP] + (size_t)l * 1024 * F2, 1024, F2, (bf16*)(ws + WS_WUP) + (size_t)l * F2 * 1024, 0, scr, r % 2816, lane); continue; } r -= N_UP;
        if (r < N_DN) { const int l = r / 1408; transpose_item(a.in[I_WDN] + (size_t)l * FF * 1024, FF, 1024, (bf16*)(ws + WS_WDN) + (size_t)l * 1024 * FF, 0, scr, r % 1408, lane); continue; } r -= N_DN;
        if (r < N_KV) { transpose_item(a.in[I_WKV], 1024, NKVC, (bf16*)(ws + WS_WKV), 0, scr, r, lane); continue; } r -= N_KV;
        if (r < N_QG) { const int j = r / 544; transpose_item(a.in[I_WQG] + (size_t)j * 1024 * NQG, 1024, NQG, (bf16*)(ws + WS_WQG) + (size_t)j * NQGP * 1024, 0, scr, r % 544, lane); continue; } r -= N_QG;
        if (r < N_O) { const int j = r / 512; transpose_item(a.in[I_WO] + (size_t)j * 1024 * 1024, 1024, 1024, (bf16*)(ws + WS_WO) + (size_t)j * 1024 * 1024, 0, scr, r % 512, lane); continue; } r -= N_O;
        if (r < N_PW) { const int lg = r / 32; transpose_item(a.in[I_POOLW] + (size_t)lg * 65536, 256, 256, (bf16*)(ws + WS_WPOOL) + (size_t)(lg >> 2) * 1024 * 256, (lg & 3) * 256, scr, r % 32, lane); continue; } r -= N_PW;
        { const int sh = r / 128; transpose_item(a.in[I_W1] + (size_t)(sh >> 1) * 2048 * 256 + (size_t)(sh & 1) * 1024 * 256, 1024, 256, (bf16*)(ws + WS_W1C) + (size_t)(sh >> 1) * 512 * 1024, (sh & 1) * 256, scr, r % 128, lane); }
    }
    { unsigned* SC = (unsigned*)(ws + WS_SC);
      for (size_t i = gt; i < 256 * 512; i += NT) { const int r = (int)(i >> 9), c = (int)(i & 511) * 2; float v0 = 0.f, v1 = 0.f;
          if (r < 2) { v0 = a.in[I_CP][r * 1024 + c]; v1 = a.in[I_CP][r * 1024 + c + 1]; } else if (r < 130) { v0 = a.in[I_CS][(r - 2) * 1024 + c]; v1 = a.in[I_CS][(r - 2) * 1024 + c + 1]; }
          SC[i] = pk2(silu_f(v0), silu_f(v1)); } }
    { for (size_t i = gt; i < 2 * 208 * 128; i += NT) { const int j = (int)(i / (208 * 128)), rem = (int)(i % (208 * 128));
          *(v4u*)((bf16*)(ws + WS_WQG) + (size_t)j * NQGP * 1024 + (size_t)NQG * 1024 + (size_t)rem * 8) = (v4u){0u, 0u, 0u, 0u}; } }
    { f32x4* X4 = (f32x4*)(ws + WS_X); const f32x4* xp = (const f32x4*)a.in[I_XP]; const f32x4* xs = (const f32x4*)a.in[I_XS];
      for (size_t i = gt; i < (size_t)MT * 256; i += NT) X4[i] = i < (size_t)MP * 256 ? xp[i] : xs[i - (size_t)MP * 256]; }
    { const f32x4* sw = (const f32x4*)a.in[I_SWIN]; f32x4* wo = (f32x4*)(a.out + O_WINS);
      for (size_t i = gt; i < (size_t)128 * 504 * 128; i += NT) { const size_t bs = i / (504 * 128), rem = i % (504 * 128); wo[bs * 512 * 128 + rem] = sw[bs * 512 * 128 + 8 * 128 + rem]; } }
    { const float* cache = a.in[I_CACHE]; const int* ptab = (const int*)a.in[I_PTAB]; bf16* Acmp = (bf16*)(ws + WS_ACMP);
      for (size_t i = gt; i < (size_t)2 * 128 * 128 * 16 * 4 * 8; i += NT) {
          const int d8 = (int)(i & 7), g = (int)((i >> 3) & 3), l = (int)((i >> 5) & 15), c = (int)((i >> 9) & 127), bs = (int)((i >> 16) & 127), slot = (int)(i >> 23);
          const int page = ptab[bs * 16 + (c >> 3)];
          const float* src = cache + ((((size_t)page * 128 + (c & 7) * 16 + l) * 4 + slot) * 4 + g) * 64 + d8 * 8;
          const f32x4 v0 = *(const f32x4*)src, v1 = *(const f32x4*)(src + 4);
          v4u o; o.x = pk2(v0[0], v0[1]); o.y = pk2(v0[2], v0[3]); o.z = pk2(v1[0], v1[1]); o.w = pk2(v1[2], v1[3]);
          *(v4u*)(Acmp + ((size_t)slot * RCMP + 4096 + (size_t)(bs * 4 + g) * 128 + c) * 1024 + l * 64 + d8 * 8) = o; } }
    if (vcu == 0) { const int slot = tid >> 8, n = tid & 255; float acc = a.in[I_B1][slot * 256 + n];
        const float* pe = a.in[I_PE] + slot * 2048; const float* w1 = a.in[I_W1] + (size_t)slot * 2048 * 256 + n;
        for (int k = 0; k < 2048; ++k) acc += pe[k] * w1[(size_t)k * 256];
        ((float*)(ws + WS_B1E))[slot * 256 + n] = acc; }
}

__device__ __forceinline__ void row_decode(int m, bool& prm, int& bq, int& t, int& ab) { prm = m < MP; if (prm) { bq = m >> 13; t = m & 8191; ab = bq; } else { const int rs = m - MP; bq = rs >> 3; t = rs & 7; ab = 2 + bq; } }

__device__ __forceinline__ void phase_pool_pre(const Args& a, int l, int vcu, int G) {
    int tid_ = threadIdx.x; asm volatile("" : "+v"(tid_)); const int lane = tid_ & 63, wave = __builtin_amdgcn_readfirstlane(tid_ >> 6); const int gw = vcu * 8 + wave, NGW = G * 8; const size_t gt = (size_t)vcu * 512 + tid_, NT = (size_t)G * 512; (void)lane; (void)gw; (void)NGW; (void)gt; (void)NT;
    unsigned char* ws = a.ws; const float* X = (const float*)(ws + WS_X); const float* ADA = (const float*)(ws + WS_ADA); bf16* U = (bf16*)(ws + WS_U);
    const float* sp = a.in[I_SPOOL];
    for (int m = gw; m < MT; m += NGW) {
        bool prm; int bq, t, ab; row_decode(m, prm, bq, t, ab);
        const float* ada = ADA + (size_t)ab * NADA + l * 6144;
#pragma unroll
        for (int j = 0; j < 4; ++j) { const int col = 256 * j + 4 * lane, w = 2 << j;
            const f32x4 sh = *(const f32x4*)(ada + col), sc = *(const f32x4*)(ada + 1024 + col) + 1.f;
            const f32x4 u = *(const f32x4*)(X + (size_t)m * 1024 + col) * sc + sh;
            f32x4 acc = u;
            for (int k = 1; k < w; ++k) { const int tt = t - k;
                if (tt >= 0) acc += *(const f32x4*)(X + (size_t)(m - k) * 1024 + col) * sc + sh;
                else if (!prm) acc += *(const f32x4*)(sp + ((size_t)(l * 128 + bq) * 15 + 15 + tt) * 1024 + col); }
            const float cnt = prm ? (float)(t + 1 < w ? t + 1 : w) : (float)w;
            const f32x4 pl = acc / cnt - u;
            v2u o; o.x = pk2(pl[0], pl[1]); o.y = pk2(pl[2], pl[3]); *(v2u*)(U + (size_t)m * 1024 + col) = o;
            if (prm) { if (t >= 8177) *(f32x4*)(a.out + O_POOLP + ((size_t)(l * 2 + bq) * 15 + (t - 8177)) * 1024 + col) = u; }
            else { float* po = a.out + O_POOLS + (size_t)(l * 128 + bq) * 15 * 1024 + col; *(f32x4*)(po + (size_t)(7 + t) * 1024) = u;
                if (t == 0) { for (int i = 0; i < 7; ++i) *(f32x4*)(po + (size_t)i * 1024) = *(const f32x4*)(sp + ((size_t)(l * 128 + bq) * 15 + 8 + i) * 1024 + col); } }
        }
    }
}

__device__ __forceinline__ void phase_ln(const Args& a, int l, int which, int vcu, int G) {
    int tid_ = threadIdx.x; asm volatile("" : "+v"(tid_)); const int lane = tid_ & 63, wave = __builtin_amdgcn_readfirstlane(tid_ >> 6); const int gw = vcu * 8 + wave, NGW = G * 8; const size_t gt = (size_t)vcu * 512 + tid_, NT = (size_t)G * 512; (void)lane; (void)gw; (void)NGW; (void)gt; (void)NT;
    unsigned char* ws = a.ws; float* X = (float*)(ws + WS_X); const float* Fb = (const float*)(ws + WS_F); const float* ADA = (const float*)(ws + WS_ADA);
    bf16* U = (bf16*)(ws + WS_U); bf16* XB = (bf16*)(ws + WS_XB);
    const float* lng = a.in[I_LNG] + (size_t)(l * 2 + which) * 1024; const float* lnb = a.in[I_LNB] + (size_t)(l * 2 + which) * 1024;
    for (int m = gw; m < MT; m += NGW) {
        bool prm; int bq, t, ab; row_decode(m, prm, bq, t, ab);
        const float* ada = ADA + (size_t)ab * NADA + l * 6144;
        const float* gate = ada + (which == 0 ? 2 : 5) * 1024;
        f32x4 v[4]; float s = 0.f;
#pragma unroll
        for (int j = 0; j < 4; ++j) { const int col = 256 * j + 4 * lane;
            const f32x4 x = *(const f32x4*)(X + (size_t)m * 1024 + col), f = *(const f32x4*)(Fb + (size_t)m * 1024 + col), gt = *(const f32x4*)(gate + col);
            v[j] = x * DN_ALPHA + (gt + 1.f) * f; s += (v[j][0] + v[j][1]) + (v[j][2] + v[j][3]); }
        const float mean = wave_sum(s) * (1.f / 1024.f); float s2 = 0.f;
#pragma unroll
        for (int j = 0; j < 4; ++j) { v[j] = v[j] - mean; s2 += (v[j][0] * v[j][0] + v[j][1] * v[j][1]) + (v[j][2] * v[j][2] + v[j][3] * v[j][3]); }
        const float rstd = 1.f / sqrtf(wave_sum(s2) * (1.f / 1024.f) + LN_EPS);
#pragma unroll
        for (int j = 0; j < 4; ++j) { const int col = 256 * j + 4 * lane;
            const f32x4 y = v[j] * rstd * *(const f32x4*)(lng + col) + *(const f32x4*)(lnb + col);
            *(f32x4*)(X + (size_t)m * 1024 + col) = y;
            if (which == 0) { const f32x4 u = y * (*(const f32x4*)(ada + 4 * 1024 + col) + 1.f) + *(const f32x4*)(ada + 3 * 1024 + col);
                v2u o; o.x = pk2(u[0], u[1]); o.y = pk2(u[2], u[3]); *(v2u*)(U + (size_t)m * 1024 + col) = o; }
            else {
                if (l == 3) { float* yo = prm ? a.out + O_YP + (size_t)m * 1024 : a.out + O_YS + (size_t)(m - MP) * 1024; *(f32x4*)(yo + col) = y; }
                else if (l >= 1) { const float* adn = ada + 6144;
                    const f32x4 u = y * (*(const f32x4*)(adn + 1024 + col) + 1.f) + *(const f32x4*)(adn + col);
                    v2u o; o.x = pk2(u[0], u[1]); o.y = pk2(u[2], u[3]); *(v2u*)(U + (size_t)m * 1024 + col) = o;
                    if (l == 1) { v2u ob; ob.x = pk2(y[0], y[1]); ob.y = pk2(y[2], y[3]); *(v2u*)(XB + (size_t)m * 1024 + col) = ob; } }
            }
        }
    }
}

__device__ __forceinline__ void phase_conv(const Args& a, int l, int vcu, int G) {
    int tid_ = threadIdx.x; asm volatile("" : "+v"(tid_)); const int lane = tid_ & 63, wave = __builtin_amdgcn_readfirstlane(tid_ >> 6); const int gw = vcu * 8 + wave, NGW = G * 8; const size_t gt = (size_t)vcu * 512 + tid_, NT = (size_t)G * 512; (void)lane; (void)gw; (void)NGW; (void)gt; (void)NT;
    unsigned char* ws = a.ws; const bf16* H = (const bf16*)(ws + WS_H); bf16* ACT = (bf16*)(ws + WS_ACT);
    const float* wc = a.in[I_WCONV] + (size_t)l * 3 * F2; const float* bc = a.in[I_BCONV] + (size_t)l * F2; const float* sconv = a.in[I_SCONV];
    for (size_t i = gt; i < (size_t)MT * 352; i += NT) {
        const int m = (int)(i / 352), col = (int)(i % 352) * 8;
        bool prm; int bq, t, ab; row_decode(m, prm, bq, t, ab);
        float hc[2][8];
#pragma unroll
        for (int part = 0; part < 2; ++part) { const int cc = col + part * FF;
            float h0[8], h1[8], h2[8];
            { const v4u w = *(const v4u*)(H + (size_t)m * F2 + cc); h0[0] = bflo(w.x); h0[1] = bfhi(w.x); h0[2] = bflo(w.y); h0[3] = bfhi(w.y); h0[4] = bflo(w.z); h0[5] = bfhi(w.z); h0[6] = bflo(w.w); h0[7] = bfhi(w.w); }
            if (t >= 1) { const v4u w = *(const v4u*)(H + (size_t)(m - 1) * F2 + cc); h1[0] = bflo(w.x); h1[1] = bfhi(w.x); h1[2] = bflo(w.y); h1[3] = bfhi(w.y); h1[4] = bflo(w.z); h1[5] = bfhi(w.z); h1[6] = bflo(w.w); h1[7] = bfhi(w.w); }
            else if (!prm) { const float* s = sconv + ((size_t)(l * 128 + bq) * 2 + 1) * F2 + cc;
#pragma unroll
                for (int e = 0; e < 8; ++e) h1[e] = s[e]; }
            else {
#pragma unroll
                for (int e = 0; e < 8; ++e) h1[e] = 0.f; }
            if (t >= 2) { const v4u w = *(const v4u*)(H + (size_t)(m - 2) * F2 + cc); h2[0] = bflo(w.x); h2[1] = bfhi(w.x); h2[2] = bflo(w.y); h2[3] = bfhi(w.y); h2[4] = bflo(w.z); h2[5] = bfhi(w.z); h2[6] = bflo(w.w); h2[7] = bfhi(w.w); }
            else if (!prm) { const float* s = sconv + ((size_t)(l * 128 + bq) * 2 + t) * F2 + cc;
#pragma unroll
                for (int e = 0; e < 8; ++e) h2[e] = s[e]; }
            else {
#pragma unroll
                for (int e = 0; e < 8; ++e) h2[e] = 0.f; }
#pragma unroll
            for (int e = 0; e < 8; ++e) hc[part][e] = bc[cc + e] + h2[e] * wc[cc + e] + h1[e] * wc[F2 + cc + e] + h0[e] * wc[2 * F2 + cc + e];
            float* so = nullptr;
            if (prm) { if (t >= 8190) so = a.out + O_CONVP + ((size_t)(l * 2 + bq) * 2 + (t - 8190)) * F2 + cc; }
            else if (t >= 6) so = a.out + O_CONVS + ((size_t)(l * 128 + bq) * 2 + (t - 6)) * F2 + cc;
            if (so) {
#pragma unroll
                for (int e = 0; e < 8; ++e) so[e] = h0[e]; }
        }
        v4u o; o.x = pk2(silu_f(hc[0][0]) * hc[1][0], silu_f(hc[0][1]) * hc[1][1]); o.y = pk2(silu_f(hc[0][2]) * hc[1][2], silu_f(hc[0][3]) * hc[1][3]);
        o.z = pk2(silu_f(hc[0][4]) * hc[1][4], silu_f(hc[0][5]) * hc[1][5]); o.w = pk2(silu_f(hc[0][6]) * hc[1][6], silu_f(hc[0][7]) * hc[1][7]);
        *(v4u*)(ACT + (size_t)m * FF + col) = o;
    }
}

__device__ __forceinline__ void phase_acmp_prompt(const Args& a, int vcu, int G) {
    int tid_ = threadIdx.x; asm volatile("" : "+v"(tid_)); const int lane = tid_ & 63, wave = __builtin_amdgcn_readfirstlane(tid_ >> 6); const int gw = vcu * 8 + wave, NGW = G * 8; const size_t gt = (size_t)vcu * 512 + tid_, NT = (size_t)G * 512; (void)lane; (void)gw; (void)NGW; (void)gt; (void)NT;
    unsigned char* ws = a.ws; const bf16* KVb = (const bf16*)(ws + WS_KVB); bf16* Acmp = (bf16*)(ws + WS_ACMP);
    for (size_t i = gt; i < (size_t)2 * 2 * 512 * 16 * 4 * 8; i += NT) {
        const int d8 = (int)(i & 7), g = (int)((i >> 3) & 3), l = (int)((i >> 5) & 15), c = (int)((i >> 9) & 511), b = (int)((i >> 18) & 1), slot = (int)(i >> 19);
        const v4u v = *(const v4u*)(KVb + ((size_t)b * 8192 + 16 * c + l) * NKVC + slot * 256 + g * 64 + d8 * 8);
        *(v4u*)(Acmp + ((size_t)slot * RCMP + (size_t)(b * 4 + g) * 512 + c) * 1024 + l * 64 + d8 * 8) = v; }
}
__device__ __forceinline__ void phase_cmp2(const Args& a, LAS unsigned char* lds, int vcu, int G) {
    int tid_ = threadIdx.x; asm volatile("" : "+v"(tid_)); const int lane = tid_ & 63, wave = __builtin_amdgcn_readfirstlane(tid_ >> 6); const int gw = vcu * 8 + wave, NGW = G * 8; const size_t gt = (size_t)vcu * 512 + tid_, NT = (size_t)G * 512; (void)lane; (void)gw; (void)NGW; (void)gt; (void)NT;
    unsigned char* ws = a.ws; const bf16* TB = (const bf16*)(ws + WS_TB); const float* b1e = (const float*)(ws + WS_B1E);
    bf16* KCp = (bf16*)(ws + WS_KCP); bf16* KCs = (bf16*)(ws + WS_KCS);
    LAS float* hid = (LAS float*)(lds + wave * 1024);
    for (int it = gw; it < 2 * RCMP; it += NGW) {
        const int slot = it >= RCMP ? 1 : 0, R = it - slot * RCMP;
        bf16* dst; bool last;
        if (R < 4096) { dst = KCp + ((size_t)slot * 4096 + R) * 64; last = (R & 511) == 511; }
        else { const int Rs = R - 4096; dst = KCs + ((size_t)slot * 65536 + Rs) * 64; last = (Rs & 127) == 127; }
        if (last) { dst[lane] = 0; continue; }
        const bf16* tp = TB + ((size_t)slot * RCMP + R) * 512 + 4 * lane; const bf16* bp = tp + 512 + 256;
        const v2u tw = *(const v2u*)tp, bw = *(const v2u*)bp; const f32x4 bb = *(const f32x4*)(b1e + slot * 256 + 4 * lane);
        f32x4 hv; hv[0] = gelu_tanh_f(bflo(tw.x) + bflo(bw.x) + bb[0]); hv[1] = gelu_tanh_f(bfhi(tw.x) + bfhi(bw.x) + bb[1]); hv[2] = gelu_tanh_f(bflo(tw.y) + bflo(bw.y) + bb[2]); hv[3] = gelu_tanh_f(bfhi(tw.y) + bfhi(bw.y) + bb[3]);
        *(LAS f32x4*)(hid + 4 * lane) = hv;
        const float* w2 = a.in[I_W2] + (size_t)slot * 256 * 64 + lane; float acc = a.in[I_B2][slot * 64 + lane];
#pragma unroll 4
        for (int n4 = 0; n4 < 64; ++n4) { const f32x4 hh = *(const LAS f32x4*)(hid + 4 * n4);
            acc += hh[0] * w2[(4 * n4) * 64] + hh[1] * w2[(4 * n4 + 1) * 64] + hh[2] * w2[(4 * n4 + 2) * 64] + hh[3] * w2[(4 * n4 + 3) * 64]; }
        dst[lane] = (bf16)f2bf(acc);
        LDS_WAIT(); asm volatile("" ::: "memory");
    }
}

#ifndef ENMASK
#define ENMASK 0xFFFFFFFFu
#endif
#ifndef ONE_LAUNCH
#define ONE_LAUNCH 0
#endif
constexpr int NPHASES = 38;
__global__ void __launch_bounds__(512, 2) nsa_fwd(Args args) {
    extern __shared__ __attribute__((aligned(16))) unsigned char lds_raw[];
    LAS unsigned char* lds = (LAS unsigned char*)lds_raw;
    const int tid = threadIdx.x;
    const int G = gridDim.x; int vcu; { const int bx = blockIdx.x; vcu = (G % 8 == 0) ? (bx % 8) * (G / 8) + bx / 8 : bx; }
    unsigned char* ws = args.ws;
    for (int u = tid; u < (LDS_BYTES - LDSCTL_OFF) / 4; u += 512) ((LAS unsigned*)(lds + LDSCTL_OFF))[u] = 0u;
    __syncthreads();
    XcdBarrier bar; bar.bar = (unsigned*)(ws + WS_CTL) + CW_BAR; bar.x = 0; bar.st = nullptr;
    if (ONE_LAUNCH) bar = xcd_barrier_post((unsigned*)(ws + WS_CTL) + CW_BAR, (volatile LAS unsigned*)(lds + MISC_OFF + 32));
    const int lo = args.ph_lo, hi = args.ph_hi; int ph = 0;
#define PH_BEGIN(k) if (((ENMASK >> (k)) & 1) && ph >= lo && ph < hi) { int Gp = G, vcup = vcu, bxp = (int)blockIdx.x; asm volatile("" : "+s"(Gp), "+s"(vcup), "+s"(bxp));
#define PH_END   if (ONE_LAUNCH && ph + 1 < hi) xcd_barrier(bar); } ++ph;

#define AdaT ((bf16*)(ws + WS_ADAT))
#define WupT ((bf16*)(ws + WS_WUP))
#define WdnT ((bf16*)(ws + WS_WDN))
#define WkvT ((bf16*)(ws + WS_WKV))
#define WqgT ((bf16*)(ws + WS_WQG))
#define WoT ((bf16*)(ws + WS_WO))
#define WpoolT ((bf16*)(ws + WS_WPOOL))
#define W1cT ((bf16*)(ws + WS_W1C))
#define SC ((bf16*)(ws + WS_SC))
#define ADA ((float*)(ws + WS_ADA))
#define Fb ((float*)(ws + WS_F))
#define U ((bf16*)(ws + WS_U))
#define XB ((bf16*)(ws + WS_XB))
#define Hb ((bf16*)(ws + WS_H))
#define ACT ((bf16*)(ws + WS_ACT))
#define KVb ((bf16*)(ws + WS_KVB))
#define Qb ((bf16*)(ws + WS_QB))
#define Gt ((float*)(ws + WS_G))
#define Ob ((bf16*)(ws + WS_OB))
#define SEL ((unsigned*)(ws + WS_SEL))
#define KCp ((bf16*)(ws + WS_KCP))
#define KCs ((bf16*)(ws + WS_KCS))
#define Acmp ((bf16*)(ws + WS_ACMP))
#define TB ((bf16*)(ws + WS_TB))
    PH_BEGIN(0) phase_prologue(args, lds, vcup, Gp); __syncthreads(); PH_END
    PH_BEGIN(1) { pg8::Gemm g{SC, AdaT, 256, NADA, 1024, 1024, 0}; pg8::StaticOrder S; S.init(256, NADA, Gp, bxp);
        pg8::EpiF32 E{ADA, NADA, args.in[I_ADAB], nullptr};
        pg8::gemm_phase<pg8::EpiF32, pg8::StaticOrder, true, true>(lds + RING_OFF, g, S, E); } PH_END

#pragma nounroll
    for (int l = 0; l < 4; ++l) {
        if (l < 2) {
            PH_BEGIN(2) phase_pool_pre(args, l, vcup, Gp); PH_END
            PH_BEGIN(3) { pg8::Gemm g{U, WpoolT + (size_t)l * 1024 * 256, MT, 1024, 256, 1024, 1}; pg8::StaticOrder S; S.init(MT, 1024, Gp, bxp);
                pg8::EpiF32 E{Fb, 1024, nullptr, args.in[I_POOLLS] + (size_t)l * 1024};
                pg8::gemm_phase<pg8::EpiF32, pg8::StaticOrder, true, true>(lds + RING_OFF, g, S, E); } PH_END
        } else {
            const int j = l - 2;
            PH_BEGIN(4) { pg8::Gemm g{U, WqgT + (size_t)j * NQGP * 1024, MT, NQGP, 1024, 1024, 0}; pg8::StaticOrder S; S.init(MT, NQGP, Gp, bxp);
                pg8::EpiQG E{Qb, Gt, att::C2};
                pg8::gemm_phase<pg8::EpiQG, pg8::StaticOrder, true, true>(lds + RING_OFF, g, S, E); } PH_END
            PH_BEGIN(5) { for (int u = vcup; u < 1024; u += Gp) { const int i = u >> 8, v = u & 255, bg = v & 7, qx = v >> 3;
                    const int qt = i == 0 ? qx : i == 1 ? 127 - qx : i == 2 ? 32 + qx : 95 - qx;
                    att::prompt_cmp_unit(bg >> 2, bg & 3, qt, Qb, KCp, Gt, SEL, Ob, (__attribute__((address_space(3))) char*)lds); }
                __syncthreads(); } PH_END
            PH_BEGIN(6) {
#if !defined(NO_SELWIN)
                for (int u = vcup; u < 1024; u += Gp) { const int i = u >> 8, v = u & 255, bh = v >> 3, s = v & 7;
                    const int qb = i == 0 ? s : i == 1 ? 15 - s : i == 2 ? 16 + s : 31 - s;
                    att::prompt_selwin_unit(bh >> 4, bh & 15, qb, Qb, KVb, Gt, SEL, Ob, (__attribute__((address_space(3))) char*)lds); }
#endif
#if !defined(NO_SAMPLE)
                att::SampleIn SI{Qb, args.out + O_KVS, args.out + O_WINS, KCs, Gt, args.in[I_CACHE], (const int*)args.in[I_PTAB], args.in[I_SWIN], Ob};
                for (int u = vcup; u < 512; u += Gp) att::sample_unit(u >> 2, u & 3, SI, (__attribute__((address_space(3))) char*)lds);
#endif
                __syncthreads(); } PH_END
            PH_BEGIN(7) { pg8::Gemm g{Ob, WoT + (size_t)j * 1024 * 1024, MT, 1024, 1024, 1024, 0}; pg8::StaticOrder S; S.init(MT, 1024, Gp, bxp);
                pg8::EpiF32 E{Fb, 1024, nullptr, nullptr};
                pg8::gemm_phase<pg8::EpiF32, pg8::StaticOrder, true, true>(lds + RING_OFF, g, S, E); } PH_END
        }
        PH_BEGIN(8) phase_ln(args, l, 0, vcup, Gp); PH_END
        PH_BEGIN(9) { pg8::Gemm g{U, WupT + (size_t)l * F2 * 1024, MT, F2, 1024, 1024, 0}; pg8::StaticOrder S; S.init(MT, F2, Gp, bxp);
            pg8::EpiB16 E{Hb, F2, args.in[I_BUP] + (size_t)l * F2};
            pg8::gemm_phase<pg8::EpiB16, pg8::StaticOrder, true, true>(lds + RING_OFF, g, S, E); } PH_END
        PH_BEGIN(10) phase_conv(args, l, vcup, Gp); PH_END
        PH_BEGIN(11) { pg8::Gemm g{ACT, WdnT + (size_t)l * 1024 * FF, MT, 1024, FF, FF, 0}; pg8::StaticOrder S; S.init(MT, 1024, Gp, bxp);
            pg8::EpiF32 E{Fb, 1024, nullptr, nullptr};
            pg8::gemm_phase<pg8::EpiF32, pg8::StaticOrder, true, true>(lds + RING_OFF, g, S, E); } PH_END
        PH_BEGIN(12) phase_ln(args, l, 1, vcup, Gp); PH_END
        if (l == 1) {
            PH_BEGIN(13) { pg8::Gemm g{XB, WkvT, MT, NKVC, 1024, 1024, 0}; pg8::StaticOrder S; S.init(MT, NKVC, Gp, bxp);
                pg8::EpiKV E{KVb, args.out + O_KVP, args.out + O_KVS, args.out + O_WINP, args.out + O_WINS};
                pg8::gemm_phase<pg8::EpiKV, pg8::StaticOrder, true, true>(lds + RING_OFF, g, S, E); } PH_END
            PH_BEGIN(14) phase_acmp_prompt(args, vcup, Gp); PH_END
            PH_BEGIN(15) { for (int slot = 0; slot < 2; ++slot) { pg8::Gemm g{Acmp + (size_t)slot * RCMP * 1024, W1cT + (size_t)slot * 512 * 1024, RCMP, 512, 1024, 1024, 0}; pg8::StaticOrder S; S.init(RCMP, 512, Gp, bxp);
                    pg8::EpiB16 E{TB + (size_t)slot * RCMP * 512, 512, nullptr};
                    pg8::gemm_phase<pg8::EpiB16, pg8::StaticOrder, true, true>(lds + RING_OFF, g, S, E); __syncthreads(); } } PH_END
            PH_BEGIN(16) phase_cmp2(args, lds, vcup, Gp); __syncthreads(); PH_END
        }
    }
#undef PH_BEGIN
#undef PH_END
}

extern "C" void kernel_launch(void* const* d_in, const int* in_sizes, int n_in, void* d_out, int out_size, void* d_ws, size_t ws_size, hipStream_t stream) {
    static int grid = 0;
    if (grid == 0) {
        if (n_in != 28 || (size_t)out_size != O_END || ws_size < WS_END) { fprintf(stderr, "kernel_launch: unexpected sizes n_in %d out %d ws %zu\n", n_in, out_size, ws_size); grid = -1; return; }
        int dev = 0, cus = 0, per_cu = 0;
        if (hipGetDevice(&dev) != hipSuccess || hipDeviceGetAttribute(&cus, hipDeviceAttributeMultiprocessorCount, dev) != hipSuccess) { grid = -1; return; }
        if (hipFuncSetAttribute((const void*)nsa_fwd, hipFuncAttributeMaxDynamicSharedMemorySize, LDS_BYTES) != hipSuccess) { fprintf(stderr, "kernel_launch: hipFuncSetAttribute failed\n"); grid = -1; return; }
        if (hipOccupancyMaxActiveBlocksPerMultiprocessor(&per_cu, (const void*)nsa_fwd, 512, LDS_BYTES) != hipSuccess || per_cu < 1) { fprintf(stderr, "kernel_launch: occupancy query says %d\n", per_cu); }
        (void)hipGetLastError();
        grid = cus;
    }
    if (grid < 0) return;
    (void)hipMemsetAsync((char*)d_ws + WS_CTL, 0, CTL_ZERO_BYTES, stream);
    Args a{};
    for (int i = 0; i < 28; ++i) a.in[i] = (const float*)d_in[i];
    a.out = (float*)d_out; a.ws = (unsigned char*)d_ws;
#if ONE_LAUNCH
    a.ph_lo = 0; a.ph_hi = NPHASES;
    hipLaunchKernelGGL(nsa_fwd, dim3(grid), dim3(512), LDS_BYTES, stream, a);
#else
    for (int p = 0; p < NPHASES; ++p) { a.ph_lo = p; a.ph_hi = p + 1; hipLaunchKernelGGL(nsa_fwd, dim3(grid), dim3(512), LDS_BYTES, stream, a); }
#endif
    const hipError_t le = hipPeekAtLastError();
    if (le != hipSuccess) fprintf(stderr, "kernel_launch: launch failed: %s\n", hipGetErrorName(le));
}
```
